# Optimizing an MI355X kernel written in HIP

```python
import jax, jax.numpy as jnp
from jax import lax
import numpy as np

D_MODEL = 1024
BATCH = 2
SEQ = 8192
DEPTH = 1

NORM_EPS = 1e-6
D_MIX = 2 * D_MODEL
GLA_HEADS = 4
GLA_DK = D_MODEL // (2 * GLA_HEADS)
GLA_DV = D_MODEL // GLA_HEADS
GLA_KEY = GLA_HEADS * GLA_DK
GLA_VAL = GLA_HEADS * GLA_DV
GLA_GATE_RANK = 16
GLA_TAU = 16.0
GLA_CHUNK = 64
SSD_INNER = D_MIX - GLA_VAL
SSD_HEAD_DIM = 64
SSD_HEADS = SSD_INNER // SSD_HEAD_DIM
SSD_GROUPS = 2
SSD_STATE = 128
SSD_CONV = 4
SSD_CHUNK = 128
SSD_CONV_DIM = SSD_INNER + 2 * SSD_GROUPS * SSD_STATE
PROJ_SIZES = (GLA_KEY, GLA_KEY, GLA_VAL, GLA_VAL, GLA_GATE_RANK,
              SSD_INNER, SSD_CONV_DIM, SSD_HEADS)
D_PROJ = sum(PROJ_SIZES)
PROJ_SPLITS = tuple(sum(PROJ_SIZES[:i + 1]) for i in range(len(PROJ_SIZES) - 1))

kernel_name = "hybrid_gla_ssd_parallel_heads"


def rms_norm(x, w, eps=NORM_EPS):
    xf = x.astype(jnp.float32)
    y = xf * lax.rsqrt(jnp.mean(xf * xf, axis=-1, keepdims=True) + eps)
    return (y * w.astype(jnp.float32)).astype(x.dtype)


def causal_depthwise_conv(u, w, b):
    out = lax.conv_general_dilated(
        u, w[:, None, :], window_strides=(1,), padding=[(w.shape[0] - 1, 0)],
        dimension_numbers=('NWC', 'WIO', 'NWC'), feature_group_count=u.shape[-1])
    return out + b


def gla_chunked(q, k, v, log_a):
    Bsz, T, H, K = q.shape
    V = v.shape[-1]
    C = GLA_CHUNK
    N = T // C
    q, k, log_a = [t.reshape(Bsz, N, C, H, K) for t in (q, k, log_a)]
    v = v.reshape(Bsz, N, C, H, V)
    b = jnp.cumsum(log_a, axis=2)
    b_last = b[:, :, -1:]
    q_dec = q * jnp.exp(b)
    k_dec = k * jnp.exp(-b)
    k_end = k * jnp.exp(b_last - b)
    causal = jnp.tril(jnp.ones((C, C), dtype=bool))
    att = jnp.einsum('bnihk,bnjhk->bnhij', q_dec, k_dec)
    att = jnp.where(causal, att, 0.0)
    o = jnp.einsum('bnhij,bnjhv->bnihv', att, v)
    kv = jnp.einsum('bnjhk,bnjhv->bnhkv', k_end, v)
    decay = jnp.exp(b_last[:, :, 0])

    def step(S, inp):
        kv_n, d_n = inp
        return S * d_n[..., None] + kv_n, S

    S0 = jnp.zeros((Bsz, H, K, V), q.dtype)
    _, S_prev = lax.scan(step, S0, (jnp.moveaxis(kv, 1, 0), jnp.moveaxis(decay, 1, 0)))
    S_prev = jnp.moveaxis(S_prev, 0, 1)
    o = o + jnp.einsum('bnihk,bnhkv->bnihv', q_dec, S_prev)
    return o.reshape(Bsz, T, H, V)


def ssd_chunked(x, dt, A, Bm, Cm):
    Bsz, T, H, P = x.shape
    G, N = Bm.shape[2], Bm.shape[3]
    Hg = H // G
    L = SSD_CHUNK
    nc = T // L
    x = x.reshape(Bsz, nc, L, G, Hg, P)
    dt = dt.reshape(Bsz, nc, L, G, Hg)
    Bm = Bm.reshape(Bsz, nc, L, G, N)
    Cm = Cm.reshape(Bsz, nc, L, G, N)
    a_cum = jnp.cumsum(dt * A.reshape(G, Hg), axis=2)
    causal = jnp.tril(jnp.ones((L, L), dtype=bool))
    seg = a_cum[:, :, :, None] - a_cum[:, :, None]
    decay_ij = jnp.exp(jnp.where(causal[:, :, None, None], seg, -jnp.inf))
    cb = jnp.einsum('bcign,bcjgn->bcijg', Cm, Bm)
    w = cb[..., None] * decay_ij * dt[:, :, None]
    y = jnp.einsum('bcijgh,bcjghp->bcighp', w, x)
    decay_end = jnp.exp(a_cum[:, :, -1:] - a_cum)
    states = jnp.einsum('bcjgn,bcjghp->bcghpn', Bm, (decay_end * dt)[..., None] * x)
    chunk_decay = jnp.exp(a_cum[:, :, -1])

    def step(S, inp):
        st, d = inp
        return S * d[..., None, None] + st, S

    S0 = jnp.zeros((Bsz, G, Hg, P, N), x.dtype)
    _, S_prev = lax.scan(step, S0, (jnp.moveaxis(states, 1, 0), jnp.moveaxis(chunk_decay, 1, 0)))
    S_prev = jnp.moveaxis(S_prev, 0, 1)
    y = y + jnp.einsum('bcign,bcghpn,bcigh->bcighp', Cm, S_prev, jnp.exp(a_cum))
    return y.reshape(Bsz, T, H, P)


def setup_inputs(seed: int = 0) -> dict:
    key = jax.random.key(seed)
    ks = jax.random.split(key, 20)
    f32 = jnp.float32
    nrm = lambda k, shape, s: jax.random.normal(k, shape, f32) * s
    dt0 = jnp.exp(jax.random.uniform(ks[10], (DEPTH, SSD_HEADS), f32,
                                     np.log(1e-3).astype(np.float32), np.log(1e-1).astype(np.float32)))
    return {
        "x": nrm(ks[0], (BATCH, SEQ, D_MODEL), 1.0),
        "c": nrm(ks[1], (BATCH, D_MODEL), 1.0),
        "ada_w": nrm(ks[2], (DEPTH, D_MODEL, 3 * D_MODEL), D_MODEL ** -0.5),
        "ada_b": nrm(ks[3], (DEPTH, 3 * D_MODEL), 0.01),
        "pre_norm_w": 1.0 + nrm(ks[4], (DEPTH, D_MODEL), 0.1),
        "w_in": nrm(ks[5], (DEPTH, D_MODEL, D_PROJ), D_MODEL ** -0.5),
        "gla_gate_w2": nrm(ks[6], (DEPTH, GLA_GATE_RANK, GLA_KEY), GLA_GATE_RANK ** -0.5),
        "gla_gate_b": nrm(ks[7], (DEPTH, GLA_KEY), 0.1),
        "gla_norm_w": 1.0 + nrm(ks[8], (DEPTH, GLA_DV), 0.1),
        "conv_w": nrm(ks[9], (DEPTH, SSD_CONV, SSD_CONV_DIM), SSD_CONV ** -0.5),
        "conv_b": nrm(ks[11], (DEPTH, SSD_CONV_DIM), 0.01),
        "dt_bias": dt0 + jnp.log(-jnp.expm1(-dt0)),
        "a_log": jnp.log(jax.random.uniform(ks[12], (DEPTH, SSD_HEADS), f32, 1.0, 16.0)),
        "d_skip": 1.0 + nrm(ks[13], (DEPTH, SSD_HEADS), 0.1),
        "ssd_norm_w": 1.0 + nrm(ks[14], (DEPTH, SSD_INNER), 0.1),
        "w_out": nrm(ks[15], (DEPTH, D_MIX, D_MODEL), D_MIX ** -0.5),
        "post_norm_w": 1.0 + nrm(ks[16], (DEPTH, D_MODEL), 0.1),
    }


def reference(x, c, ada_w, ada_b, pre_norm_w, w_in, gla_gate_w2, gla_gate_b, gla_norm_w,
              conv_w, conv_b, dt_bias, a_log, d_skip, ssd_norm_w, w_out, post_norm_w):
    f32 = jnp.float32
    Bsz, T, _ = x.shape
    c_act = jax.nn.silu(c)
    for i in range(DEPTH):
        ada = c_act @ ada_w[i] + ada_b[i]
        shift, scale, gate = jnp.split(ada, 3, axis=-1)
        h = rms_norm(x, pre_norm_w[i]) * (1.0 + scale[:, None]) + shift[:, None]
        proj = h @ w_in[i]
        q, k, v, g, gate_lr, z, xbc, dt_raw = jnp.split(proj, PROJ_SPLITS, axis=-1)

        qh = q.reshape(Bsz, T, GLA_HEADS, GLA_DK).astype(f32) * (GLA_DK ** -0.5)
        kh = k.reshape(Bsz, T, GLA_HEADS, GLA_DK).astype(f32)
        vh = v.reshape(Bsz, T, GLA_HEADS, GLA_DV).astype(f32)
        log_a = jax.nn.log_sigmoid((gate_lr @ gla_gate_w2[i] + gla_gate_b[i]).astype(f32)) / GLA_TAU
        o = gla_chunked(qh, kh, vh, log_a.reshape(Bsz, T, GLA_HEADS, GLA_DK))
        o = rms_norm(o, gla_norm_w[i]).astype(x.dtype).reshape(Bsz, T, GLA_VAL)
        o = o * jax.nn.silu(g)

        xbc = jax.nn.silu(causal_depthwise_conv(xbc, conv_w[i], conv_b[i]))
        xs, Bm, Cm = jnp.split(xbc, [SSD_INNER, SSD_INNER + SSD_GROUPS * SSD_STATE], axis=-1)
        dt = jax.nn.softplus(dt_raw.astype(f32) + dt_bias[i].astype(f32))
        A = -jnp.exp(a_log[i].astype(f32))
        xs_h = xs.reshape(Bsz, T, SSD_HEADS, SSD_HEAD_DIM).astype(f32)
        y = ssd_chunked(xs_h, dt, A,
                        Bm.reshape(Bsz, T, SSD_GROUPS, SSD_STATE).astype(f32),
                        Cm.reshape(Bsz, T, SSD_GROUPS, SSD_STATE).astype(f32))
        y = y + d_skip[i].astype(f32)[:, None] * xs_h
        y = y.reshape(Bsz, T, SSD_INNER).astype(x.dtype) * jax.nn.silu(z)
        y = rms_norm(y.reshape(Bsz, T, SSD_GROUPS, SSD_INNER // SSD_GROUPS),
                     ssd_norm_w[i].reshape(SSD_GROUPS, SSD_INNER // SSD_GROUPS))
        y = y.reshape(Bsz, T, SSD_INNER)

        mixed = jnp.concatenate([o, y], axis=-1) @ w_out[i]
        x = x + gate[:, None] * rms_norm(mixed, post_norm_w[i])
    return x
```

```cpp
#include <hip/hip_runtime.h>
#include <hip/hip_cooperative_groups.h>
#include <cstdio>
#include <cstdint>
namespace cg = cooperative_groups;
namespace pg8 {
#define PG8_LAS __attribute__((address_space(3)))
typedef unsigned short bf16_t;
typedef short bf16x8 __attribute__((ext_vector_type(8)));
typedef float f32x4 __attribute__((ext_vector_type(4)));
typedef unsigned u32x4 __attribute__((ext_vector_type(4)));
constexpr int BM = 256, BK = 64, HALF = 128, HTB = HALF * BK * 2  , STAGE_BYTES = 8 * HTB, NXCD = 8, WGM = 8;

__host__ __device__ __forceinline__ int lds_byte(int r, int c) { const int st = (r >> 4) * 2 + (c >> 5), rr = r & 15, cc = c & 31, ob = rr * 64 + cc * 2; return st * 1024 + (ob ^ (((ob >> 9) & 1) << 5)); }
__host__ __device__ __forceinline__ void stage_rc(int b, int& R, int& C) { const int st = b / 1024, sb = b % 1024, swz = sb ^ (((sb >> 9) & 1) << 5); R = (st >> 1) * 16 + swz / 64; C = (st & 1) * 32 + (swz % 64) / 2; }
__host__ __device__ __forceinline__ int perm32(int rho) { const int n = rho >> 4, i = rho & 15; return 8 * (i >> 2) + 4 * n + (i & 3); }

struct Unit { int pm, pn; };
struct Gemm { const bf16_t* A; const bf16_t* Bt; int M, N, K, lda, ldb; };

struct StaticOrder {
    int nM, nN, nwg, G, c;
    __host__ __device__ void init(int M, int N, int G_, int c_) { nM = M / BM; nN = N / BM; nwg = nM * nN; G = G_; c = c_; }
    __host__ __device__ bool next(int i, Unit& u) const {
        const long L = (long)i * G + c; if (L >= nwg) return false;
        int wgid = (int)L; { const int q = nwg / NXCD, r = nwg % NXCD, xcd = wgid % NXCD, off = wgid / NXCD; wgid = (xcd < r ? xcd * (q + 1) : r * (q + 1) + (xcd - r) * q) + off; }
        const int nig = WGM * nN, gid = wgid / nig, fm = gid * WGM, gsz = (nM - fm) < WGM ? (nM - fm) : WGM;
        u.pm = fm + ((wgid % nig) % gsz); u.pn = (wgid % nig) / gsz; return true;
    }
    __device__ __forceinline__ void a_ready(const Unit&) const {}
    __device__ __forceinline__ void done(const Unit&) const {}
};

__device__ __forceinline__ unsigned cvt_pk_bf16(float lo, float hi) { unsigned r; asm volatile("v_cvt_pk_bf16_f32 %0, %1, %2" : "=v"(r) : "v"(lo), "v"(hi)); return r; }
typedef float f32x2 __attribute__((ext_vector_type(2)));
__device__ __forceinline__ f32x2 gelu_pk(f32x2 v) {
    const f32x2 av = __builtin_elementwise_abs(v), d = av * 0.2316418882f + 1.0f;
    f32x2 t; t.x = __builtin_amdgcn_rcpf(d.x); t.y = __builtin_amdgcn_rcpf(d.y);
    f32x2 q = t * 0.5307027145f + (-0.7265760135f); q = q * t + 0.7107068705f; q = q * t + (-0.142248368f); q = q * t + 0.127414796f; q = q * t;
    const f32x2 s = (v * v) * (-0.72134752044f);
    f32x2 e; e.x = __builtin_amdgcn_exp2f(s.x); e.y = __builtin_amdgcn_exp2f(s.y);
    const f32x2 m = v * (q * e), r = v - m;
    f32x2 o; o.x = v.x < 0.f ? m.x : r.x; o.y = v.y < 0.f ? m.y : r.y; return o;
}

template <int ACT  > struct EpiBf16 {
    static constexpr bool PERM = true, AFTER_DRAIN = false; static_assert(ACT == 0 || ACT == 1, "EpiBf16: ACT is 0 (none) or 1 (gelu_pk)");
    bf16_t* O; int ldc; const float* bias; int split_cols; size_t split_stride; float scale0;
    __device__ __forceinline__ void operator()(const f32x4 (&acc)[2][2][4][2], const Unit& u, int wr, int wc, int fr, int fq) const {
        const int row0 = u.pm * BM + wr * 64 + fr; int colt = u.pn * BM; bf16_t* base = O;
        float sc = 1.f; if (split_cols) { const int t = colt / split_cols; base += (size_t)t * split_stride; colt -= t * split_cols; if (t == 0) sc = scale0; }
        const int col0 = colt + wc * 32 + 8 * fq, bcol0 = u.pn * BM + wc * 32 + 8 * fq;
        f32x4 bv[2][2];
#pragma unroll
        for (int bj = 0; bj < 2; ++bj)
#pragma unroll
            for (int n = 0; n < 2; ++n) bv[bj][n] = bias ? *(const f32x4*)(bias + bcol0 + bj * HALF + 4 * n) : (f32x4){0.f, 0.f, 0.f, 0.f};
#pragma unroll
        for (int ai = 0; ai < 2; ++ai)
#pragma unroll
            for (int m = 0; m < 4; ++m) { bf16_t* rowp = base + (size_t)(row0 + ai * HALF + m * 16) * ldc + col0;
#pragma unroll
                for (int bj = 0; bj < 2; ++bj) { f32x4 v0 = acc[ai][bj][m][0] + bv[bj][0], v1 = acc[ai][bj][m][1] + bv[bj][1];
                    if (ACT == 1) { f32x2 a = gelu_pk((f32x2){v0[0], v0[1]}), b = gelu_pk((f32x2){v0[2], v0[3]}), c = gelu_pk((f32x2){v1[0], v1[1]}), d = gelu_pk((f32x2){v1[2], v1[3]});
                        v0 = (f32x4){a.x, a.y, b.x, b.y}; v1 = (f32x4){c.x, c.y, d.x, d.y}; }
                    v0 = v0 * sc; v1 = v1 * sc; u32x4 w; w.x = cvt_pk_bf16(v0[0], v0[1]); w.y = cvt_pk_bf16(v0[2], v0[3]); w.z = cvt_pk_bf16(v1[0], v1[1]); w.w = cvt_pk_bf16(v1[2], v1[3]);
                    *(u32x4*)(rowp + bj * HALF) = w; } }
    }
};
template <class Epi, class Sched, bool ALIGN_EPI = false, bool SP2 = false>
__device__ __forceinline__ void gemm_phase(PG8_LAS unsigned char* lds, const Gemm g, const Sched& S, const Epi& E) {
    const int tid = threadIdx.x, wid = __builtin_amdgcn_readfirstlane(tid >> 6), lane = tid & 63, wr = wid >> 2, wc = wid & 3, fr = lane & 15, fq = lane >> 4;
    const int K = g.K, nt = K / BK;
    unsigned voffA[2], voffB[2];
#pragma unroll
    for (int i = 0; i < 2; ++i) { int R, C; stage_rc(tid * 16 + i * 8192, R, C); const int Rb = Epi::PERM ? ((R & ~31) + perm32(R & 31)) : R;
        voffA[i] = (unsigned)(R * g.lda + C) * 2u; voffB[i] = (unsigned)(Rb * g.ldb + C) * 2u; }
    const size_t kstep = (size_t)(BK * 2);
    const size_t hstepA = (size_t)HALF * g.lda * 2, hstepB = (size_t)HALF * g.ldb * 2;
    const size_t tstepA = 2 * hstepA, tstepB = 2 * hstepB;
    const unsigned ldsw = (unsigned)wid * 1024u;
    const int aoff = lds_byte(wr * 64 + fr, fq * 8), boff = lds_byte(wc * 32 + fr, fq * 8);
#define PG8_SA(b, h) (((b) * 2 + (h)) * HTB)
#define PG8_SB(b, h) ((4 + (b) * 2 + (h)) * HTB)
#define PG8_STAGE(bufoff, gbase, voff) do { _Pragma("unroll") for (int _i = 0; _i < 2; ++_i) \
        __builtin_amdgcn_global_load_lds((const unsigned*)((const char*)(gbase) + (voff)[_i]), (PG8_LAS unsigned*)(lds + (bufoff) + ldsw + _i * 8192), 16, 0, 0); } while (0)
#define PG8_LDA(dst, b, h) do { _Pragma("unroll") for (int m = 0; m < 4; ++m) _Pragma("unroll") for (int k = 0; k < 2; ++k) dst[m][k] = *(const PG8_LAS bf16x8*)(lds + PG8_SA(b, h) + aoff + m * 2048 + k * 1024); } while (0)
#define PG8_LDB(dst, b, h) do { _Pragma("unroll") for (int n = 0; n < 2; ++n) _Pragma("unroll") for (int k = 0; k < 2; ++k) dst[n][k] = *(const PG8_LAS bf16x8*)(lds + PG8_SB(b, h) + boff + n * 2048 + k * 1024); } while (0)
#define PG8_MMA(ai, bj, At, Bt) do { __builtin_amdgcn_s_setprio(1); _Pragma("unroll") for (int m = 0; m < 4; ++m) _Pragma("unroll") for (int n = 0; n < 2; ++n) _Pragma("unroll") for (int k = 0; k < 2; ++k) \
        acc[ai][bj][m][n] = __builtin_amdgcn_mfma_f32_16x16x32_bf16(Bt[n][k], At[m][k], acc[ai][bj][m][n], 0, 0, 0); __builtin_amdgcn_s_setprio(0); } while (0)
#define PG8_WAIT_V(n) asm volatile("s_waitcnt vmcnt(" #n ")" ::: "memory")
#define PG8_WAIT_L(n) asm volatile("s_waitcnt lgkmcnt(" #n ")" ::: "memory")
#define PG8_BAR __builtin_amdgcn_s_barrier()
#define PG8_SCHED __builtin_amdgcn_sched_barrier(0)
    Unit cur, nxt; int ui = 0;
    if (!S.next(0, cur)) return;
    f32x4 acc[2][2][4][2];
#pragma unroll
    for (int a = 0; a < 2; ++a)
#pragma unroll
        for (int b = 0; b < 2; ++b)
#pragma unroll
            for (int m = 0; m < 4; ++m)
#pragma unroll
                for (int n = 0; n < 2; ++n) acc[a][b][m][n] = (f32x4){0.f, 0.f, 0.f, 0.f};
    bf16x8 At[4][2], B0[2][2], B1[2][2];
    const char* cA = (const char*)g.A + (size_t)cur.pm * tstepA; const char* cB = (const char*)g.Bt + (size_t)cur.pn * tstepB;
    S.a_ready(cur);
    if constexpr (SP2) {
        PG8_STAGE(PG8_SB(0, 0), cB, voffB); PG8_STAGE(PG8_SB(0, 1), cB + hstepB, voffB); PG8_STAGE(PG8_SA(0, 0), cA, voffA); PG8_STAGE(PG8_SA(0, 1), cA + hstepA, voffA);
        if (wr == 1) PG8_BAR;
        PG8_WAIT_V(2); PG8_BAR;
        PG8_STAGE(PG8_SB(1, 0), cB + kstep, voffB); PG8_STAGE(PG8_SA(1, 0), cA + kstep, voffA); PG8_STAGE(PG8_SB(1, 1), cB + hstepB + kstep, voffB);
        PG8_WAIT_V(6); PG8_BAR;
    } else {
        PG8_STAGE(PG8_SB(0, 0), cB, voffB); PG8_STAGE(PG8_SA(0, 0), cA, voffA); PG8_STAGE(PG8_SB(0, 1), cB + hstepB, voffB); PG8_STAGE(PG8_SA(0, 1), cA + hstepA, voffA);
        if (wr == 1) PG8_BAR;
        PG8_WAIT_V(4); PG8_BAR;
        PG8_STAGE(PG8_SB(1, 0), cB + kstep, voffB); PG8_STAGE(PG8_SA(1, 0), cA + kstep, voffA); PG8_STAGE(PG8_SB(1, 1), cB + hstepB + kstep, voffB);
        PG8_WAIT_V(6); PG8_BAR;
    }
    for (;;) {
        const bool has_next = S.next(ui + 1, nxt);
        const char* nA = has_next ? (const char*)g.A + (size_t)nxt.pm * tstepA : cA; const char* nB = has_next ? (const char*)g.Bt + (size_t)nxt.pn * tstepB : cB;
        for (int t = 0; t < nt; t += 2) {
            const bool last = (t == nt - 2);
            const char* a1 = cA + (size_t)(t + 1) * kstep;
            const char* a2 = last ? nA : cA + (size_t)(t + 2) * kstep; const char* b2 = last ? nB : cB + (size_t)(t + 2) * kstep;
            const char* a3 = a2 + kstep; const char* b3 = b2 + kstep;
            if (last && has_next) S.a_ready(nxt);
            if constexpr (SP2) {
            PG8_LDB(B0, 0, 0); PG8_LDB(B1, 0, 1); PG8_SCHED; PG8_LDA(At, 0, 0); PG8_STAGE(PG8_SA(1, 1), a1 + hstepA, voffA);
            PG8_WAIT_V(8); PG8_WAIT_L(0); PG8_BAR; PG8_MMA(0, 0, At, B0); PG8_MMA(0, 1, At, B1); PG8_BAR; PG8_SCHED;
            PG8_LDA(At, 0, 1); PG8_STAGE(PG8_SB(0, 0), b2, voffB); PG8_STAGE(PG8_SB(0, 1), b2 + hstepB, voffB); PG8_STAGE(PG8_SA(0, 0), a2, voffA);
            PG8_WAIT_V(8); PG8_WAIT_L(0); PG8_BAR; PG8_MMA(1, 0, At, B0); PG8_MMA(1, 1, At, B1); PG8_BAR; PG8_SCHED;
            PG8_LDB(B0, 1, 0); PG8_LDB(B1, 1, 1); PG8_SCHED; PG8_LDA(At, 1, 0); PG8_STAGE(PG8_SA(0, 1), a2 + hstepA, voffA);
            PG8_WAIT_V(8); PG8_WAIT_L(0); PG8_BAR; PG8_MMA(0, 0, At, B0); PG8_MMA(0, 1, At, B1); PG8_BAR; PG8_SCHED;
            PG8_LDA(At, 1, 1); PG8_STAGE(PG8_SB(1, 0), b3, voffB); PG8_STAGE(PG8_SB(1, 1), b3 + hstepB, voffB); PG8_STAGE(PG8_SA(1, 0), a3, voffA);
            PG8_WAIT_V(8); PG8_WAIT_L(0); PG8_BAR; PG8_MMA(1, 0, At, B0); PG8_MMA(1, 1, At, B1); PG8_BAR; PG8_SCHED;
            } else {
            PG8_LDB(B0, 0, 0); PG8_SCHED; PG8_LDA(At, 0, 0); PG8_STAGE(PG8_SA(1, 1), a1 + hstepA, voffA);
            PG8_WAIT_L(8); PG8_BAR; PG8_WAIT_L(0); PG8_MMA(0, 0, At, B0); PG8_BAR; PG8_SCHED;
            PG8_LDB(B1, 0, 1); PG8_STAGE(PG8_SB(0, 0), b2, voffB);
            PG8_BAR; PG8_WAIT_L(0); PG8_MMA(0, 1, At, B1); PG8_BAR;
            PG8_LDA(At, 0, 1); PG8_STAGE(PG8_SA(0, 0), a2, voffA);
            PG8_BAR; PG8_WAIT_L(0); PG8_MMA(1, 0, At, B0); PG8_BAR; PG8_SCHED;
            PG8_STAGE(PG8_SB(0, 1), b2 + hstepB, voffB);
            PG8_WAIT_V(6); PG8_BAR; PG8_MMA(1, 1, At, B1); PG8_BAR;
            PG8_LDB(B0, 1, 0); PG8_SCHED; PG8_LDA(At, 1, 0); PG8_STAGE(PG8_SA(0, 1), a2 + hstepA, voffA);
            PG8_WAIT_L(8); PG8_BAR; PG8_WAIT_L(0); PG8_MMA(0, 0, At, B0); PG8_BAR; PG8_SCHED;
            PG8_LDB(B1, 1, 1); PG8_STAGE(PG8_SB(1, 0), b3, voffB);
            PG8_BAR; PG8_WAIT_L(0); PG8_MMA(0, 1, At, B1); PG8_BAR;
            PG8_LDA(At, 1, 1); PG8_STAGE(PG8_SA(1, 0), a3, voffA);
            PG8_BAR; PG8_WAIT_L(0); PG8_MMA(1, 0, At, B0); PG8_BAR; PG8_SCHED;
            PG8_STAGE(PG8_SB(1, 1), b3 + hstepB, voffB);
            PG8_WAIT_V(6); PG8_BAR; PG8_MMA(1, 1, At, B1); PG8_BAR;
            }
        }
        if constexpr (ALIGN_EPI) { if (wr == 0) PG8_BAR; }
        if constexpr (!Epi::AFTER_DRAIN) { E(acc, cur, wr, wc, fr, fq); S.done(cur); }
        if (!has_next) break;
#pragma unroll
        for (int a = 0; a < 2; ++a)
#pragma unroll
            for (int b = 0; b < 2; ++b)
#pragma unroll
                for (int m = 0; m < 4; ++m)
#pragma unroll
                    for (int n = 0; n < 2; ++n) acc[a][b][m][n] = (f32x4){0.f, 0.f, 0.f, 0.f};
        cur = nxt; cA = nA; cB = nB; ++ui;
        if constexpr (ALIGN_EPI) { if (wr == 1) PG8_BAR; }
    }
    PG8_WAIT_V(0);
    if constexpr (!ALIGN_EPI) { if (wr == 0) PG8_BAR; }
    PG8_BAR;
    if constexpr (Epi::AFTER_DRAIN) { E.fused(acc, cur, wr, wc, fr, fq, lds, wid, lane); S.done(cur); }
#undef PG8_SA
#undef PG8_SB
#undef PG8_STAGE
#undef PG8_LDA
#undef PG8_LDB
#undef PG8_MMA
#undef PG8_WAIT_V
#undef PG8_WAIT_L
#undef PG8_BAR
#undef PG8_SCHED
}
}

#ifndef MK_N_LAUNCHES
#define MK_N_LAUNCHES 1
#endif
constexpr int NWAVES = 8, NTHR = 512, NPHASE = 11;
constexpr int BATCH = 2, T = 8192, D = 1024, M = BATCH * T;
constexpr int DPROJ = 5664, DMIX = 2048;
constexpr int NPN = 3840, NPT = 2048, NWT = NPN + NPT;
constexpr int CN_G = 0, CN_Z = 1024, CN_Q = 2048, CN_K = 2560, CN_B = 3072, CN_C = 3328, CN_GL = 3584, CN_DT = 3600, CN_PAD = 3616;
constexpr float EPS = 1e-6f;
constexpr size_t MiB = 1u << 20;
constexpr size_t WS_ADA = 0, WS_SDEC = 32 * 1024, WS_GDEC = 64 * 1024;
constexpr size_t WS_WOUT = 1 * MiB, WS_WT = 5 * MiB, WS_H = 17 * MiB, WS_PN = 49 * MiB, WS_PT = 169 * MiB, WS_END = 233 * MiB;
constexpr size_t WS_SS = 5 * MiB;
constexpr int LDS_BYTES = 147456;

#define LAS __attribute__((address_space(3)))
typedef unsigned short bf16_t;
typedef short bf16x8 __attribute__((ext_vector_type(8)));
typedef float f32x4 __attribute__((ext_vector_type(4)));
typedef float f32x2 __attribute__((ext_vector_type(2)));
typedef unsigned u32x4 __attribute__((ext_vector_type(4)));
typedef unsigned u32x2 __attribute__((ext_vector_type(2)));
#define LDS_WAIT() asm volatile("s_waitcnt lgkmcnt(0)" ::: "memory")

__device__ __forceinline__ float bf2f(unsigned b) { return __uint_as_float(b << 16); }
__device__ __forceinline__ float bflo(unsigned u) { return __uint_as_float(u << 16); }
__device__ __forceinline__ float bfhi(unsigned u) { return __uint_as_float(u & 0xffff0000u); }
typedef __bf16 bf16x2_t __attribute__((ext_vector_type(2)));
__device__ __forceinline__ unsigned pk2(float lo, float hi) { const f32x2 v = {lo, hi}; const bf16x2_t b = __builtin_convertvector(v, bf16x2_t); return __builtin_bit_cast(unsigned, b); }
__device__ __forceinline__ bf16_t f2bf(float f) { const __bf16 b = (__bf16)f; return __builtin_bit_cast(unsigned short, b); }
__device__ __forceinline__ void st_wt8(void* p, u32x2 v) { __hip_atomic_store((unsigned long long*)p, ((unsigned long long)v.y << 32) | v.x, __ATOMIC_RELAXED, __HIP_MEMORY_SCOPE_AGENT); }
__device__ __forceinline__ void st_wt4(void* p, unsigned v) { __hip_atomic_store((unsigned*)p, v, __ATOMIC_RELAXED, __HIP_MEMORY_SCOPE_AGENT); }
__device__ __forceinline__ float silu_f(float x) { return x / (1.f + __expf(-x)); }
__device__ __forceinline__ float wave_sum(float v) {
#pragma unroll
    for (int o = 1; o < 64; o <<= 1) v += __shfl_xor(v, o);
    return v;
}
__device__ __forceinline__ f32x4 mma16(bf16x8 arow, bf16x8 brow, f32x4 acc) { return __builtin_amdgcn_mfma_f32_16x16x32_bf16(brow, arow, acc, 0, 0, 0); }
__device__ __forceinline__ bf16x8 lfrag(const LAS bf16_t* base, int row, int pitch, int k) { return *(const LAS bf16x8*)(base + row * pitch + k); }
__device__ __forceinline__ bf16x8 gfrag(const bf16_t* p) { return *(const bf16x8*)p; }

__device__ __forceinline__ bf16_t* sg_item(unsigned char* sg, int item) { return (bf16_t*)sg + (size_t)item * 32768; }
__device__ __forceinline__ int win_dest(int n) {
    if (n < 512) return CN_Q + n;
    if (n < 1024) return CN_K + (n - 512);
    if (n < 2048) return NPN + (n - 1024);
    if (n < 3072) return CN_G + (n - 2048);
    if (n < 3088) return CN_GL + (n - 3072);
    if (n < 4112) return CN_Z + (n - 3088);
    if (n < 5136) return NPN + 1024 + (n - 4112);
    if (n < 5392) return CN_B + (n - 5136);
    if (n < 5648) return CN_C + (n - 5392);
    return CN_DT + (n - 5648);
}

template <bool WIN>
__device__ __forceinline__ void transpose_item(const float* __restrict__ W, int K, int N, bf16_t* __restrict__ WT, LAS float* scr, int item, int lane) {
    const int nblk = N / 32, kb = item / nblk, nb = item % nblk, k0 = 64 * kb, n0 = 32 * nb;
#pragma unroll 8
    for (int i = 0; i < 32; ++i) { const int kk = 2 * i + (lane >> 5); scr[kk * 33 + (lane & 31)] = W[(size_t)(k0 + kk) * N + n0 + (lane & 31)]; }
    LDS_WAIT();
    const int c = lane & 7;
#pragma unroll
    for (int j = 0; j < 4; ++j) {
        const int n = (lane >> 3) + 8 * j; const LAS float* s = scr + (8 * c) * 33 + n;
        u32x4 o; o.x = pk2(s[0 * 33], s[1 * 33]); o.y = pk2(s[2 * 33], s[3 * 33]); o.z = pk2(s[4 * 33], s[5 * 33]); o.w = pk2(s[6 * 33], s[7 * 33]);
        const int dr = WIN ? win_dest(n0 + n) : (n0 + n);
        *(u32x4*)(WT + (size_t)dr * K + k0 + 8 * c) = o;
    }
    LDS_WAIT();
}

__device__ __forceinline__ void phase0(LAS unsigned char* lds, const float* __restrict__ c_in, const float* __restrict__ ada_w, const float* __restrict__ ada_b,
                                       const float* __restrict__ w_in, const float* __restrict__ w_out, unsigned char* ws, int tid, int wave, int lane) {
    bf16_t* WT = (bf16_t*)(ws + WS_WT); bf16_t* WOT = (bf16_t*)(ws + WS_WOUT); float* ada = (float*)(ws + WS_ADA);
    const int G = gridDim.x;
    for (int it = blockIdx.x; it < 192; it += G) {
        LAS float* red = (LAS float*)(lds + 8 * 16384);
        const int n0 = 16 * it, kk = lane >> 4, nn = lane & 15;
        float a0 = 0.f, a1 = 0.f;
#pragma unroll 8
        for (int i = 0; i < 32; ++i) {
            const int k = 128 * wave + 4 * i + kk;
            const float wv = ada_w[(size_t)k * 3072 + n0 + nn];
            a0 += silu_f(c_in[k]) * wv; a1 += silu_f(c_in[D + k]) * wv;
        }
        a0 += __shfl_xor(a0, 16); a0 += __shfl_xor(a0, 32); a1 += __shfl_xor(a1, 16); a1 += __shfl_xor(a1, 32);
        if (lane < 16) { red[(wave * 2 + 0) * 16 + nn] = a0; red[(wave * 2 + 1) * 16 + nn] = a1; }
        __syncthreads();
        if (tid < 32) { const int b = tid >> 4, n = tid & 15; float s = ada_b[n0 + n];
#pragma unroll
            for (int w = 0; w < 8; ++w) s += red[(w * 2 + b) * 16 + n];
            ada[b * 3072 + n0 + n] = s; }
        __syncthreads();
    }
    LAS float* scr = (LAS float*)(lds + wave * 16384);
    const int gw = blockIdx.x * NWAVES + wave, NGW = G * NWAVES;
    constexpr int I_IN = (D / 64) * (DPROJ / 32), I_OUT = (DMIX / 64) * (D / 32);
    for (int it = gw; it < I_IN + I_OUT; it += NGW) {
        if (it < I_IN) transpose_item<true>(w_in, D, DPROJ, WT, scr, it, lane);
        else transpose_item<false>(w_out, DMIX, D, WOT, scr, it - I_IN, lane);
    }
#ifdef POISON_SS
    { const int gt = blockIdx.x * NTHR + tid, GT = G * NTHR; u32x4* z = (u32x4*)(ws + POISON_SS);
      for (int i = gt; i < (int)(32 * MiB / 16); i += GT) z[i] = (u32x4){0x7fc07fc0u, 0x7fc07fc0u, 0x7fc07fc0u, 0x7fc07fc0u}; }
#endif
    { const int gt = blockIdx.x * NTHR + tid, GT = G * NTHR; u32x4* z = (u32x4*)(WT + (size_t)CN_PAD * D);
      for (int i = gt; i < (NPN - CN_PAD) * D / 8; i += GT) z[i] = (u32x4){0u, 0u, 0u, 0u}; }
}

__device__ __forceinline__ void phase1(const float* __restrict__ x, const float* __restrict__ pre_w, const unsigned char* ws_c, bf16_t* __restrict__ H, int wave, int lane) {
    const float* ada = (const float*)(ws_c + WS_ADA);
    const int gw = blockIdx.x * NWAVES + wave, NGW = gridDim.x * NWAVES;
    for (int m = gw; m < M; m += NGW) {
        const int b = m >> 13;
        const f32x4* xr = (const f32x4*)(x + (size_t)m * D) + lane;
        f32x4 v[4]; float s = 0.f;
#pragma unroll
        for (int j = 0; j < 4; ++j) { v[j] = xr[64 * j]; s += (v[j].x * v[j].x + v[j].y * v[j].y) + (v[j].z * v[j].z + v[j].w * v[j].w); }
        const float rstd = rsqrtf(wave_sum(s) * (1.f / D) + EPS);
        unsigned long long* o8 = (unsigned long long*)(H + (size_t)m * D) + lane;
#pragma unroll
        for (int j = 0; j < 4; ++j) {
            const int col = 4 * lane + 256 * j;
            const f32x4 w = *(const f32x4*)(pre_w + col), sh = *(const f32x4*)(ada + b * 3072 + col), sc = *(const f32x4*)(ada + b * 3072 + 1024 + col);
            const f32x4 hv = (v[j] * rstd) * w * (sc + 1.f) + sh;
            o8[64 * j] = (unsigned long long)pk2(hv.x, hv.y) | ((unsigned long long)pk2(hv.z, hv.w) << 32);
        }
    }
}

constexpr int GL_OFF_GLR = 0, GL_OFF_PART = 4096, GL_OFF_RED = 6144, GL_OFF_A = 8192, GL_OFF_B = 26624, GL_OFF_ATT = 44032;
template <int MODE>
__device__ __forceinline__ void gla_prep(LAS unsigned char* lds, const bf16_t* __restrict__ PN, const float* __restrict__ w2, const float* __restrict__ gbias, float* gdec, int t0, int h, int tid) {
    LAS float* glr = (LAS float*)(lds + GL_OFF_GLR);
    LAS float* part = (LAS float*)(lds + GL_OFF_PART);
    for (int idx = tid; idx < 1024; idx += NTHR) glr[idx] = bf2f(PN[(size_t)(t0 + (idx >> 4)) * NPN + CN_GL + (idx & 15)]);
    const int k = tid & 127, jq = tid >> 7;
    float w[16];
#pragma unroll
    for (int r = 0; r < 16; ++r) w[r] = w2[r * 512 + h * 128 + k];
    const float bias = gbias[h * 128 + k];
    __syncthreads();
    float pre[16]; float run = 0.f;
#pragma unroll
    for (int jj = 0; jj < 16; ++jj) {
        const LAS f32x4* g4 = (const LAS f32x4*)(glr + (jq * 16 + jj) * 16);
        float xg = bias;
#pragma unroll
        for (int r4 = 0; r4 < 4; ++r4) { const f32x4 gv = g4[r4]; xg += gv.x * w[4 * r4]; xg += gv.y * w[4 * r4 + 1]; xg += gv.z * w[4 * r4 + 2]; xg += gv.w * w[4 * r4 + 3]; }
        const float ls = fminf(xg, 0.f) - __logf(1.f + __expf(-fabsf(xg)));
        run += ls * (1.f / 16.f);
        pre[jj] = run;
    }
    part[jq * 128 + k] = run;
    __syncthreads();
    float off = 0.f, tot = 0.f;
#pragma unroll
    for (int q = 0; q < 4; ++q) { const float p = part[q * 128 + k]; off += (q < jq) ? p : 0.f; tot += p; }
    if (MODE == 0) {
        LAS bf16_t* KeT = (LAS bf16_t*)(lds + GL_OFF_A);
        const bf16_t* kp = PN + (size_t)(t0 + jq * 16) * NPN + CN_K + h * 128 + k;
#pragma unroll
        for (int jj = 0; jj < 16; jj += 2) {
            const float k0 = bf2f(kp[(size_t)jj * NPN]), k1 = bf2f(kp[(size_t)(jj + 1) * NPN]);
            const float e0 = __expf(tot - (off + pre[jj])), e1 = __expf(tot - (off + pre[jj + 1]));
            *(LAS unsigned*)(KeT + k * 72 + jq * 16 + jj) = pk2(k0 * e0, k1 * e1);
        }
        if (jq == 0) gdec[k] = __expf(tot);
    } else {
        LAS bf16_t* Qd = (LAS bf16_t*)(lds + GL_OFF_A); LAS bf16_t* Kd = (LAS bf16_t*)(lds + GL_OFF_B);
        const bf16_t* qp = PN + (size_t)(t0 + jq * 16) * NPN + CN_Q + h * 128 + k;
        const bf16_t* kp = PN + (size_t)(t0 + jq * 16) * NPN + CN_K + h * 128 + k;
#pragma unroll
        for (int jj = 0; jj < 16; ++jj) {
            const float bb = off + pre[jj];
            const float qv = bf2f(qp[(size_t)jj * NPN]) * 0.08838834764831845f * __expf(bb);
            const float kv = bf2f(kp[(size_t)jj * NPN]) * __expf(-bb);
            Qd[(jq * 16 + jj) * 136 + k] = f2bf(qv); Kd[(jq * 16 + jj) * 136 + k] = f2bf(kv);
        }
    }
}

__device__ __forceinline__ void gla_state_item(LAS unsigned char* lds, const bf16_t* __restrict__ PN, const bf16_t* __restrict__ PT, const float* __restrict__ w2, const float* __restrict__ gbias,
                                               float* gdec, unsigned char* ws, int item, int tid, int wave, int lane) {
    const int h = item & 3, t0 = (item >> 2) * 64;
    gla_prep<0>(lds, PN, w2, gbias, gdec + (size_t)item * 128, t0, h, tid);
    const int fr = lane & 15, fq = lane >> 4;
    bf16x8 av[2][2];
#pragma unroll
    for (int mt = 0; mt < 2; ++mt)
#pragma unroll
        for (int ks = 0; ks < 2; ++ks) av[mt][ks] = gfrag(PT + (size_t)(h * 256 + wave * 32 + mt * 16 + fr) * M + t0 + ks * 32 + 8 * fq);
    __syncthreads();
    const LAS bf16_t* KeT = (const LAS bf16_t*)(lds + GL_OFF_A);
    f32x4 acc[2][8];
#pragma unroll
    for (int mt = 0; mt < 2; ++mt)
#pragma unroll
        for (int nt = 0; nt < 8; ++nt) acc[mt][nt] = (f32x4){0.f, 0.f, 0.f, 0.f};
#pragma unroll
    for (int nt = 0; nt < 8; ++nt)
#pragma unroll
        for (int ks = 0; ks < 2; ++ks) {
            const bf16x8 bfg = lfrag(KeT, nt * 16 + fr, 72, ks * 32 + 8 * fq);
#pragma unroll
            for (int mt = 0; mt < 2; ++mt) acc[mt][nt] = mma16(av[mt][ks], bfg, acc[mt][nt]);
        }
    bf16_t* So = sg_item(ws, item);
#pragma unroll
    for (int mt = 0; mt < 2; ++mt)
#pragma unroll
        for (int nt = 0; nt < 8; ++nt) {
            const int v = wave * 32 + mt * 16 + fr, kk = nt * 16 + 4 * fq;
            u32x2 o; o.x = pk2(acc[mt][nt][0], acc[mt][nt][1]); o.y = pk2(acc[mt][nt][2], acc[mt][nt][3]);
            st_wt8(So + v * 128 + kk, o);
        }
    __syncthreads();
}

__device__ __forceinline__ void gla_out_item(LAS unsigned char* lds, bf16_t* __restrict__ PN, const bf16_t* __restrict__ PT, const float* __restrict__ w2, const float* __restrict__ gbias,
                                             const float* __restrict__ gnw, unsigned char* ws, int item, int tid, int wave, int lane) {
    const int h = item & 3, t0 = (item >> 2) * 64;
    gla_prep<1>(lds, PN, w2, gbias, nullptr, t0, h, tid);
    __syncthreads();
    const int fr = lane & 15, fq = lane >> 4;
    const LAS bf16_t* Qd = (const LAS bf16_t*)(lds + GL_OFF_A); const LAS bf16_t* Kd = (const LAS bf16_t*)(lds + GL_OFF_B);
    LAS bf16_t* att = (LAS bf16_t*)(lds + GL_OFF_ATT);
    {
        const int mt = wave >> 1;
#pragma unroll
        for (int e = 0; e < 2; ++e) {
            const int nt = (wave & 1) * 2 + e;
            f32x4 a = (f32x4){0.f, 0.f, 0.f, 0.f};
            if (nt <= mt) {
#pragma unroll
                for (int ks = 0; ks < 4; ++ks) a = mma16(lfrag(Qd, mt * 16 + fr, 136, ks * 32 + 8 * fq), lfrag(Kd, nt * 16 + fr, 136, ks * 32 + 8 * fq), a);
            }
            const int i = mt * 16 + fr, j0 = nt * 16 + 4 * fq;
            const float v0 = (j0 + 0 <= i) ? a[0] : 0.f, v1 = (j0 + 1 <= i) ? a[1] : 0.f, v2 = (j0 + 2 <= i) ? a[2] : 0.f, v3 = (j0 + 3 <= i) ? a[3] : 0.f;
            u32x2 o; o.x = pk2(v0, v1); o.y = pk2(v2, v3);
            *(LAS u32x2*)(att + i * 72 + j0) = o;
        }
    }
    __syncthreads();
    f32x4 acc[4][2];
#pragma unroll
    for (int mt = 0; mt < 4; ++mt)
#pragma unroll
        for (int nt = 0; nt < 2; ++nt) acc[mt][nt] = (f32x4){0.f, 0.f, 0.f, 0.f};
#pragma unroll
    for (int ks = 0; ks < 2; ++ks) {
        bf16x8 bv[2];
#pragma unroll
        for (int nt = 0; nt < 2; ++nt) bv[nt] = gfrag(PT + (size_t)(h * 256 + wave * 32 + nt * 16 + fr) * M + t0 + ks * 32 + 8 * fq);
#pragma unroll
        for (int mt = 0; mt < 4; ++mt) {
            if (ks == 1 && mt < 2) continue;
            const bf16x8 af = lfrag(att, mt * 16 + fr, 72, ks * 32 + 8 * fq);
#pragma unroll
            for (int nt = 0; nt < 2; ++nt) acc[mt][nt] = mma16(af, bv[nt], acc[mt][nt]);
        }
    }
    const bf16_t* Sp = sg_item(ws, item);
#pragma unroll
    for (int ks = 0; ks < 4; ++ks) {
        bf16x8 bs[2];
#pragma unroll
        for (int nt = 0; nt < 2; ++nt) bs[nt] = gfrag(Sp + (wave * 32 + nt * 16 + fr) * 128 + ks * 32 + 8 * fq);
#pragma unroll
        for (int mt = 0; mt < 4; ++mt) {
            const bf16x8 af = lfrag(Qd, mt * 16 + fr, 136, ks * 32 + 8 * fq);
#pragma unroll
            for (int nt = 0; nt < 2; ++nt) acc[mt][nt] = mma16(af, bs[nt], acc[mt][nt]);
        }
    }
    LAS float* red = (LAS float*)(lds + GL_OFF_RED);
#pragma unroll
    for (int mt = 0; mt < 4; ++mt) {
        float s = 0.f;
#pragma unroll
        for (int nt = 0; nt < 2; ++nt) { const f32x4 a = acc[mt][nt]; s += (a[0] * a[0] + a[1] * a[1]) + (a[2] * a[2] + a[3] * a[3]); }
        s += __shfl_xor(s, 16); s += __shfl_xor(s, 32);
        if (fq == 0) red[wave * 64 + mt * 16 + fr] = s;
    }
    __syncthreads();
#pragma unroll
    for (int mt = 0; mt < 4; ++mt) {
        const int i = mt * 16 + fr;
        float tot = 0.f;
#pragma unroll
        for (int w = 0; w < 8; ++w) tot += red[w * 64 + i];
        const float rstd = rsqrtf(tot * (1.f / 256.f) + EPS);
#pragma unroll
        for (int nt = 0; nt < 2; ++nt) {
            const int v0 = wave * 32 + nt * 16 + 4 * fq;
            const f32x4 nw = *(const f32x4*)(gnw + v0);
            bf16_t* gp = PN + (size_t)(t0 + i) * NPN + CN_G + h * 256 + v0;
            const u32x2 gr = *(const u32x2*)gp;
            const f32x4 a = acc[mt][nt];
            u32x2 o;
            o.x = pk2(a[0] * rstd * nw[0] * silu_f(bflo(gr.x)), a[1] * rstd * nw[1] * silu_f(bfhi(gr.x)));
            o.y = pk2(a[2] * rstd * nw[2] * silu_f(bflo(gr.y)), a[3] * rstd * nw[3] * silu_f(bfhi(gr.y)));
            *(u32x2*)gp = o;
        }
    }
    __syncthreads();
}

constexpr int SS_OFF_DT = 0, SS_OFF_AC = 4096;
constexpr int S3_OFF_BT = 8192, S3_OFF_XT = 43008;
constexpr int S5_OFF_CN = 8192, S5_OFF_BN = 43008, S5_OFF_WH = 77824, S5_OFF_XT = 112640;

__device__ __forceinline__ void ssd_dt_prep(LAS unsigned char* lds, const bf16_t* __restrict__ PN, const float* __restrict__ dt_bias, const float* __restrict__ a_log, int t0, int g, int tid, int wave, int lane) {
    LAS float* dtL = (LAS float*)(lds + SS_OFF_DT); LAS float* acL = (LAS float*)(lds + SS_OFF_AC);
    const int j = tid & 127, hq = tid >> 7;
#pragma unroll
    for (int e = 0; e < 2; ++e) {
        const int hh = hq * 2 + e, hd = g * 8 + hh;
        const float raw = bf2f(PN[(size_t)(t0 + j) * NPN + CN_DT + hd]) + dt_bias[hd];
        const float dt = raw > 20.f ? raw : log1pf(__expf(raw));
        dtL[hh * 128 + j] = dt; acL[hh * 128 + j] = -dt * __expf(a_log[hd]);
    }
    __syncthreads();
    {
        const float v0 = acL[wave * 128 + 2 * lane], v1 = acL[wave * 128 + 2 * lane + 1];
        float s = v0 + v1;
#pragma unroll
        for (int o = 1; o < 64; o <<= 1) { const float t = __shfl_up(s, o); s += (lane >= o) ? t : 0.f; }
        const float ex = s - (v0 + v1);
        acL[wave * 128 + 2 * lane] = ex + v0; acL[wave * 128 + 2 * lane + 1] = ex + v0 + v1;
    }
    __syncthreads();
}
__device__ __forceinline__ void conv8_nat(const bf16_t* __restrict__ PN, const float* __restrict__ cw, const float* __restrict__ cb, int tok, int pos, int col, int ch0, float (&out)[8]) {
    { const f32x4 b0 = *(const f32x4*)(cb + ch0), b1 = *(const f32x4*)(cb + ch0 + 4);
      out[0] = b0[0]; out[1] = b0[1]; out[2] = b0[2]; out[3] = b0[3]; out[4] = b1[0]; out[5] = b1[1]; out[6] = b1[2]; out[7] = b1[3]; }
#pragma unroll
    for (int tp = 0; tp < 4; ++tp) {
        {
            const bool ok = (pos - 3 + tp) >= 0;
            u32x4 raw = *(const u32x4*)(PN + (size_t)(ok ? tok - 3 + tp : tok) * NPN + col);
            raw.x = ok ? raw.x : 0u; raw.y = ok ? raw.y : 0u; raw.z = ok ? raw.z : 0u; raw.w = ok ? raw.w : 0u;
            const f32x4 w0 = *(const f32x4*)(cw + tp * 1536 + ch0), w1 = *(const f32x4*)(cw + tp * 1536 + ch0 + 4);
            out[0] += w0[0] * bflo(raw.x); out[1] += w0[1] * bfhi(raw.x); out[2] += w0[2] * bflo(raw.y); out[3] += w0[3] * bfhi(raw.y);
            out[4] += w1[0] * bflo(raw.z); out[5] += w1[1] * bfhi(raw.z); out[6] += w1[2] * bflo(raw.w); out[7] += w1[3] * bfhi(raw.w);
        }
    }
#pragma unroll
    for (int e = 0; e < 8; ++e) out[e] = silu_f(out[e]);
}
__device__ __forceinline__ void conv8_tr(const bf16_t* __restrict__ PT, const float* __restrict__ cw, const float* __restrict__ cb, int row, int tcol, bool has_prev, int ch, float (&out)[8]) {
    const u32x4 cur = *(const u32x4*)(PT + (size_t)row * M + tcol);
    u32x4 prv = *(const u32x4*)(PT + (size_t)row * M + tcol - (has_prev ? 8 : 0));
    prv.z = has_prev ? prv.z : 0u; prv.w = has_prev ? prv.w : 0u;
    float u[11];
    u[0] = bfhi(prv.z); u[1] = bflo(prv.w); u[2] = bfhi(prv.w);
    u[3] = bflo(cur.x); u[4] = bfhi(cur.x); u[5] = bflo(cur.y); u[6] = bfhi(cur.y); u[7] = bflo(cur.z); u[8] = bfhi(cur.z); u[9] = bflo(cur.w); u[10] = bfhi(cur.w);
    const float w0 = cw[ch], w1 = cw[1536 + ch], w2 = cw[2 * 1536 + ch], w3 = cw[3 * 1536 + ch], bias = cb[ch];
#pragma unroll
    for (int e = 0; e < 8; ++e) out[e] = silu_f(bias + w0 * u[e] + w1 * u[e + 1] + w2 * u[e + 2] + w3 * u[e + 3]);
}

__device__ __forceinline__ void ssd_state_item(LAS unsigned char* lds, const bf16_t* __restrict__ PN, const bf16_t* __restrict__ PT, const float* __restrict__ cw, const float* __restrict__ cb,
                                               const float* __restrict__ dt_bias, const float* __restrict__ a_log, float* sdec, bf16_t* SS, int item, int tid, int wave, int lane) {
    const int g = item & 1, bc = item >> 1, c = bc & 63, t0 = bc * 128;
    ssd_dt_prep(lds, PN, dt_bias, a_log, t0, g, tid, wave, lane);
    const LAS float* dtL = (const LAS float*)(lds + SS_OFF_DT); const LAS float* acL = (const LAS float*)(lds + SS_OFF_AC);
    LAS bf16_t* BT = (LAS bf16_t*)(lds + S3_OFF_BT); LAS bf16_t* XT = (LAS bf16_t*)(lds + S3_OFF_XT);
    for (int idx = tid; idx < 2048; idx += NTHR) {
        const int j = idx & 127, cc = idx >> 7;
        float o[8];
        conv8_nat(PN, cw, cb, t0 + j, c * 128 + j, CN_B + g * 128 + 8 * cc, 1024 + g * 128 + 8 * cc, o);
#pragma unroll
        for (int e = 0; e < 8; ++e) BT[(8 * cc + e) * 136 + j] = f2bf(o[e]);
    }
    if (tid < 8) sdec[bc * 16 + g * 8 + tid] = __expf(acL[tid * 128 + 127]);
    __syncthreads();
    const int fr = lane & 15, fq = lane >> 4;
#pragma unroll 1
    for (int hh = 0; hh < 8; ++hh) {
        const int hd = g * 8 + hh;
        const float alast = acL[hh * 128 + 127];
        for (int idx = tid; idx < 1024; idx += NTHR) {
            const int jc = idx & 15, p = idx >> 4;
            float o[8];
            conv8_tr(PT, cw, cb, 1024 + hd * 64 + p, t0 + 8 * jc, (c * 128 + 8 * jc) > 0, hd * 64 + p, o);
#pragma unroll
            for (int e = 0; e < 8; ++e) { const int j = 8 * jc + e; o[e] *= dtL[hh * 128 + j] * __expf(alast - acL[hh * 128 + j]); }
            u32x4 pk; pk.x = pk2(o[0], o[1]); pk.y = pk2(o[2], o[3]); pk.z = pk2(o[4], o[5]); pk.w = pk2(o[6], o[7]);
            *(LAS u32x4*)(XT + p * 136 + 8 * jc) = pk;
        }
        __syncthreads();
        const int mt = wave & 3, nh = wave >> 2;
        f32x4 acc[4];
#pragma unroll
        for (int n4 = 0; n4 < 4; ++n4) acc[n4] = (f32x4){0.f, 0.f, 0.f, 0.f};
#pragma unroll
        for (int ks = 0; ks < 4; ++ks) {
            const bf16x8 af = lfrag(XT, mt * 16 + fr, 136, ks * 32 + 8 * fq);
#pragma unroll
            for (int n4 = 0; n4 < 4; ++n4) acc[n4] = mma16(af, lfrag(BT, (nh * 4 + n4) * 16 + fr, 136, ks * 32 + 8 * fq), acc[n4]);
        }
        bf16_t* So = SS + (size_t)(bc * 16 + hd) * 8192;
#pragma unroll
        for (int n4 = 0; n4 < 4; ++n4) {
            u32x2 o; o.x = pk2(acc[n4][0], acc[n4][1]); o.y = pk2(acc[n4][2], acc[n4][3]);
            st_wt8(So + (mt * 16 + fr) * 128 + (nh * 4 + n4) * 16 + 4 * fq, o);
        }
        __syncthreads();
    }
}

__device__ __forceinline__ void ssd_out_item(LAS unsigned char* lds, bf16_t* __restrict__ PN, const bf16_t* __restrict__ PT, const float* __restrict__ cw, const float* __restrict__ cb,
                                             const float* __restrict__ dt_bias, const float* __restrict__ a_log, const float* __restrict__ d_skip, const float* __restrict__ snw,
                                             const bf16_t* __restrict__ SS, int item, int tid, int wave, int lane) {
    const int g = item & 1, bc = item >> 1, c = bc & 63, t0 = bc * 128;
    ssd_dt_prep(lds, PN, dt_bias, a_log, t0, g, tid, wave, lane);
    const LAS float* dtL = (const LAS float*)(lds + SS_OFF_DT); const LAS float* acL = (const LAS float*)(lds + SS_OFF_AC);
    LAS bf16_t* Cn = (LAS bf16_t*)(lds + S5_OFF_CN); LAS bf16_t* Bn = (LAS bf16_t*)(lds + S5_OFF_BN);
    LAS bf16_t* Wh = (LAS bf16_t*)(lds + S5_OFF_WH); LAS bf16_t* XT = (LAS bf16_t*)(lds + S5_OFF_XT);
    for (int idx = tid; idx < 4096; idx += NTHR) {
        const int cc = idx & 15, j = (idx >> 4) & 127, which = idx >> 11;
        float o[8];
        conv8_nat(PN, cw, cb, t0 + j, c * 128 + j, (which ? CN_C : CN_B) + g * 128 + 8 * cc, 1024 + which * 256 + g * 128 + 8 * cc, o);
        u32x4 pk; pk.x = pk2(o[0], o[1]); pk.y = pk2(o[2], o[3]); pk.z = pk2(o[4], o[5]); pk.w = pk2(o[6], o[7]);
        *(LAS u32x4*)((which ? Cn : Bn) + j * 136 + 8 * cc) = pk;
    }
    __syncthreads();
    const int fr = lane & 15, fq = lane >> 4;
    bf16x8 cf[4];
#pragma unroll
    for (int ks = 0; ks < 4; ++ks) cf[ks] = lfrag(Cn, wave * 16 + fr, 136, ks * 32 + 8 * fq);
    f32x4 cbv[8];
#pragma unroll
    for (int nt = 0; nt < 8; ++nt) {
        cbv[nt] = (f32x4){0.f, 0.f, 0.f, 0.f};
        if (nt <= wave) {
#pragma unroll
            for (int ks = 0; ks < 4; ++ks) cbv[nt] = mma16(cf[ks], lfrag(Bn, nt * 16 + fr, 136, ks * 32 + 8 * fq), cbv[nt]);
        }
    }
    const int i = wave * 16 + fr;
    float ss = 0.f;
#pragma unroll 1
    for (int hh = 0; hh < 8; ++hh) {
        const int hd = g * 8 + hh;
        for (int idx = tid; idx < 1024; idx += NTHR) {
            const int jc = idx & 15, p = idx >> 4;
            float o[8];
            conv8_tr(PT, cw, cb, 1024 + hd * 64 + p, t0 + 8 * jc, (c * 128 + 8 * jc) > 0, hd * 64 + p, o);
            u32x4 pk; pk.x = pk2(o[0], o[1]); pk.y = pk2(o[2], o[3]); pk.z = pk2(o[4], o[5]); pk.w = pk2(o[6], o[7]);
            *(LAS u32x4*)(XT + p * 136 + 8 * jc) = pk;
        }
        const float aci = acL[hh * 128 + i];
#pragma unroll
        for (int nt = 0; nt < 8; ++nt) {
            if (nt <= (wave | 1)) {
                const int j0 = nt * 16 + 4 * fq;
                const f32x4 acj = *(const LAS f32x4*)(acL + hh * 128 + j0), dtj = *(const LAS f32x4*)(dtL + hh * 128 + j0);
                float v[4];
#pragma unroll
                for (int r = 0; r < 4; ++r) { const float t = cbv[nt][r] * __expf(aci - acj[r]) * dtj[r]; v[r] = (j0 + r <= i) ? t : 0.f; }
                u32x2 o; o.x = pk2(v[0], v[1]); o.y = pk2(v[2], v[3]);
                *(LAS u32x2*)(Wh + i * 136 + j0) = o;
            }
        }
        __syncthreads();
        f32x4 y1[4], y2[4];
#pragma unroll
        for (int nt = 0; nt < 4; ++nt) { y1[nt] = (f32x4){0.f, 0.f, 0.f, 0.f}; y2[nt] = (f32x4){0.f, 0.f, 0.f, 0.f}; }
#ifndef SSD_NO_Y1
#pragma unroll
        for (int ks = 0; ks < 4; ++ks) {
            if (ks <= (wave >> 1)) {
                const bf16x8 af = lfrag(Wh, wave * 16 + fr, 136, ks * 32 + 8 * fq);
#pragma unroll
                for (int nt = 0; nt < 4; ++nt) y1[nt] = mma16(af, lfrag(XT, nt * 16 + fr, 136, ks * 32 + 8 * fq), y1[nt]);
            }
        }
#endif
        const bf16_t* Sp = SS + (size_t)(bc * 16 + hd) * 8192;
#ifndef SSD_NO_Y2
#pragma unroll
        for (int ks = 0; ks < 4; ++ks)
#pragma unroll
            for (int nt = 0; nt < 4; ++nt) y2[nt] = mma16(cf[ks], gfrag(Sp + (nt * 16 + fr) * 128 + ks * 32 + 8 * fq), y2[nt]);
#endif
        const float eai = __expf(aci), Dh = d_skip[hd];
#pragma unroll
        for (int nt = 0; nt < 4; ++nt) {
            const int p0 = nt * 16 + 4 * fq;
            bf16_t* zp = PN + (size_t)(t0 + i) * NPN + CN_Z + hd * 64 + p0;
            const u32x2 zr = *(const u32x2*)zp;
            float yz[4];
#pragma unroll
            for (int r = 0; r < 4; ++r) {
                const float xv = bf2f(XT[(p0 + r) * 136 + i]);
                const float y = y1[nt][r] + eai * y2[nt][r] + Dh * xv;
                const float z = (r == 0) ? bflo(zr.x) : (r == 1) ? bfhi(zr.x) : (r == 2) ? bflo(zr.y) : bfhi(zr.y);
                yz[r] = y * silu_f(z);
                ss += yz[r] * yz[r];
            }
            u32x2 yo; yo.x = pk2(yz[0], yz[1]); yo.y = pk2(yz[2], yz[3]);
            *(u32x2*)zp = yo;
        }
        __syncthreads();
    }
    ss += __shfl_xor(ss, 16); ss += __shfl_xor(ss, 32);
    const float rstd = rsqrtf(ss * (1.f / 512.f) + EPS);
#pragma unroll 2
    for (int hh = 0; hh < 8; ++hh)
#pragma unroll
        for (int nt = 0; nt < 4; ++nt) {
            const int p0 = nt * 16 + 4 * fq, hd = g * 8 + hh;
            const f32x4 nw = *(const f32x4*)(snw + g * 512 + hh * 64 + p0);
            bf16_t* zp = PN + (size_t)(t0 + i) * NPN + CN_Z + hd * 64 + p0;
            const u32x2 yv = *(const u32x2*)zp;
            u32x2 o;
            o.x = pk2(bflo(yv.x) * rstd * nw[0], bfhi(yv.x) * rstd * nw[1]);
            o.y = pk2(bflo(yv.y) * rstd * nw[2], bfhi(yv.y) * rstd * nw[3]);
            *(u32x2*)zp = o;
        }
    __syncthreads();
}

__device__ __forceinline__ void scan_gla(unsigned char* ws, const float* __restrict__ gdec, int tid) {
    const int gt = blockIdx.x * NTHR + tid, GT = gridDim.x * NTHR;
    for (int w = gt; w < 8 * 16384; w += GT) {
        const int bh = w >> 14, e2 = w & 16383, b = bh >> 2, h = bh & 3, kk = (2 * e2) & 127;
        bf16_t* p = sg_item(ws, b * 512 + h) + 2 * e2;
        const float* dp = gdec + (size_t)(b * 512 + h) * 128 + kk;
        float s0 = 0.f, s1 = 0.f;
        for (int n0 = 0; n0 < 128; n0 += 8) {
            unsigned u[8]; f32x2 d[8];
#pragma unroll
            for (int q = 0; q < 8; ++q) { u[q] = *(const unsigned*)(p + (size_t)(n0 + q) * 131072); d[q] = *(const f32x2*)(dp + (n0 + q) * 512); }
#pragma unroll
            for (int q = 0; q < 8; ++q) { st_wt4(p + (size_t)(n0 + q) * 131072, pk2(s0, s1)); s0 = s0 * d[q].x + bflo(u[q]); s1 = s1 * d[q].y + bfhi(u[q]); }
        }
    }
}
__device__ __forceinline__ void scan_ssd(bf16_t* SS, const float* __restrict__ sdec, int tid) {
    const int gt = blockIdx.x * NTHR + tid, GT = gridDim.x * NTHR;
    for (int w = gt; w < 32 * 4096; w += GT) {
        const int bh = w >> 12, e2 = w & 4095, b = bh >> 4, h = bh & 15;
        bf16_t* p = SS + (size_t)(b * 1024 + h) * 8192 + 2 * e2;
        const float* dp = sdec + b * 1024 + h;
        float s0 = 0.f, s1 = 0.f;
        for (int c0 = 0; c0 < 64; c0 += 8) {
            unsigned u[8]; float d[8];
#pragma unroll
            for (int q = 0; q < 8; ++q) { u[q] = *(const unsigned*)(p + (size_t)(c0 + q) * 131072); d[q] = dp[(c0 + q) * 16]; }
#pragma unroll
            for (int q = 0; q < 8; ++q) { st_wt4(p + (size_t)(c0 + q) * 131072, pk2(s0, s1)); s0 = s0 * d[q] + bflo(u[q]); s1 = s1 * d[q] + bfhi(u[q]); }
        }
    }
}

__device__ __forceinline__ void phase7(const float* __restrict__ x, const bf16_t* __restrict__ MX, const float* __restrict__ post_w, const unsigned char* ws_c, float* __restrict__ out, int wave, int lane) {
    const float* ada = (const float*)(ws_c + WS_ADA);
    const int gw = blockIdx.x * NWAVES + wave, NGW = gridDim.x * NWAVES;
    for (int m = gw; m < M; m += NGW) {
        const int b = m >> 13;
        float v[16]; float s = 0.f;
#pragma unroll
        for (int jj = 0; jj < 2; ++jj) {
            const u32x4 r = *(const u32x4*)(MX + (size_t)m * D + 512 * jj + 8 * lane);
            v[8 * jj + 0] = bflo(r.x); v[8 * jj + 1] = bfhi(r.x); v[8 * jj + 2] = bflo(r.y); v[8 * jj + 3] = bfhi(r.y);
            v[8 * jj + 4] = bflo(r.z); v[8 * jj + 5] = bfhi(r.z); v[8 * jj + 6] = bflo(r.w); v[8 * jj + 7] = bfhi(r.w);
        }
#pragma unroll
        for (int e = 0; e < 16; ++e) s += v[e] * v[e];
        const float rstd = rsqrtf(wave_sum(s) * (1.f / D) + EPS);
#pragma unroll
        for (int jj = 0; jj < 2; ++jj)
#pragma unroll
            for (int q = 0; q < 2; ++q) {
                const int col = 512 * jj + 8 * lane + 4 * q;
                const f32x4 xv = *(const f32x4*)(x + (size_t)m * D + col), gt = *(const f32x4*)(ada + b * 3072 + 2048 + col), pw = *(const f32x4*)(post_w + col);
                f32x4 o;
                o[0] = xv[0] + gt[0] * (v[8 * jj + 4 * q + 0] * rstd * pw[0]); o[1] = xv[1] + gt[1] * (v[8 * jj + 4 * q + 1] * rstd * pw[1]);
                o[2] = xv[2] + gt[2] * (v[8 * jj + 4 * q + 2] * rstd * pw[2]); o[3] = xv[3] + gt[3] * (v[8 * jj + 4 * q + 3] * rstd * pw[3]);
                *(f32x4*)(out + (size_t)m * D + col) = o;
            }
    }
}

struct Args { const float* in[17]; float* out; unsigned char* ws; int ph_lo, ph_hi; };
__device__ __forceinline__ const float* karg(int i) { const float* const* ka = (const float* const*)__builtin_amdgcn_kernarg_segment_ptr(); asm volatile("" : "+s"(ka)); return ka[i]; }
__global__ void __launch_bounds__(NTHR, 2) fwd_megakernel(Args args) {
    extern __shared__ __attribute__((aligned(16))) unsigned char lds_raw[];
    LAS unsigned char* lds = (LAS unsigned char*)lds_raw;
    cg::grid_group grid = cg::this_grid();
    const int tid = threadIdx.x, lane = tid & 63, wave = __builtin_amdgcn_readfirstlane(tid >> 6);
    const int G = gridDim.x;
    unsigned char* ws = args.ws;
    bf16_t* WT = (bf16_t*)(ws + WS_WT); bf16_t* WOT = (bf16_t*)(ws + WS_WOUT); bf16_t* H = (bf16_t*)(ws + WS_H);
    bf16_t* PN = (bf16_t*)(ws + WS_PN); bf16_t* PT = (bf16_t*)(ws + WS_PT);
    bf16_t* SS = (bf16_t*)(ws + WS_SS);
    bf16_t* MX = (bf16_t*)(ws + WS_PT);
    float* gdec = (float*)(ws + WS_GDEC); float* sdec = (float*)(ws + WS_SDEC);
    const int lo = args.ph_lo, hi = args.ph_hi;
#define IN(k) (lo <= (k) && (k) < hi)
#define SEAM(k) do { if (IN(k) && IN((k) + 1)) { grid.sync(); asm volatile("buffer_inv sc0 sc1\n\ts_waitcnt vmcnt(0)" ::: "memory"); __syncthreads(); } } while (0)

#ifndef SKIP0
    if (IN(0)) { phase0(lds, karg(1), karg(2), karg(3), karg(5), karg(15), ws, tid, wave, lane); }
#endif
    SEAM(0);
#ifndef SKIP1
    if (IN(1)) { phase1(karg(0), karg(4), ws, H, wave, lane); }
#endif
    SEAM(1);
#ifndef SKIP2
    if (IN(2)) {
        { pg8::Gemm g{H, WT, M, NPN, D, D, D}; pg8::StaticOrder S; S.init(M, NPN, G, (int)blockIdx.x);
          pg8::EpiBf16<0> E{PN, NPN, nullptr, 0, 0, 1.f};
          pg8::gemm_phase<pg8::EpiBf16<0>, pg8::StaticOrder, true, true>(lds, g, S, E); }
        { pg8::Gemm g{WT + (size_t)NPN * D, H, NPT, M, D, D, D}; pg8::StaticOrder S; S.init(NPT, M, G, (int)blockIdx.x);
          pg8::EpiBf16<0> E{PT, M, nullptr, 0, 0, 1.f};
          pg8::gemm_phase<pg8::EpiBf16<0>, pg8::StaticOrder, true, true>(lds, g, S, E); }
    }
#endif
    SEAM(2);
#ifndef SKIP3
    if (IN(3)) { for (int it = blockIdx.x; it < 1024; it += G) gla_state_item(lds, PN, PT, karg(6), karg(7), gdec, (unsigned char*)args.out, it, tid, wave, lane); }
#endif
    SEAM(3);
#ifndef SKIP4
    if (IN(4)) { scan_gla((unsigned char*)args.out, gdec, tid); }
#endif
    SEAM(4);
#ifndef SKIP5
    if (IN(5)) { for (int it = blockIdx.x; it < 1024; it += G) gla_out_item(lds, PN, PT, karg(6), karg(7), karg(8), (unsigned char*)args.out, it, tid, wave, lane); }
#endif
    SEAM(5);
#ifndef SKIP6
    if (IN(6)) { for (int it = blockIdx.x; it < 256; it += G) ssd_state_item(lds, PN, PT, karg(9), karg(10), karg(11), karg(12), sdec, SS, it, tid, wave, lane); }
#endif
    SEAM(6);
#ifndef SKIP7
    if (IN(7)) { scan_ssd(SS, sdec, tid); }
#endif
    SEAM(7);
#ifndef SKIP8
    if (IN(8)) { for (int it = blockIdx.x; it < 256; it += G) ssd_out_item(lds, PN, PT, karg(9), karg(10), karg(11), karg(12), karg(13), karg(14), SS, it, tid, wave, lane); }
#endif
    SEAM(8);
#ifndef SKIP9
    if (IN(9)) {
        pg8::Gemm g{PN, WOT, M, D, DMIX, NPN, DMIX}; pg8::StaticOrder S; S.init(M, D, G, (int)blockIdx.x);
        pg8::EpiBf16<0> E{MX, D, nullptr, 0, 0, 1.f};
        pg8::gemm_phase<pg8::EpiBf16<0>, pg8::StaticOrder, true, true>(lds, g, S, E);
    }
#endif
    SEAM(9);
#ifndef SKIP10
    if (IN(10)) { phase7(karg(0), MX, karg(16), ws, (float*)karg(17), wave, lane); }
#endif
#undef IN
#undef SEAM
}

extern "C" void kernel_launch(void* const* d_in, const int* in_sizes, int n_in, void* d_out, int out_size, void* d_ws, size_t ws_size, hipStream_t stream) {
    static int grid = 0;
    if (grid == 0) {
        if (n_in != 17 || out_size != M * D || ws_size < WS_END) { fprintf(stderr, "kernel_launch: unexpected shapes (n_in %d, out %d, ws %zu)\n", n_in, out_size, ws_size); grid = -1; return; }
        int dev = 0, cus = 0, per_cu = 0;
        hipGetDevice(&dev);
        hipDeviceGetAttribute(&cus, hipDeviceAttributeMultiprocessorCount, dev);
        if (hipFuncSetAttribute((const void*)fwd_megakernel, hipFuncAttributeMaxDynamicSharedMemorySize, LDS_BYTES) != hipSuccess) { fprintf(stderr, "kernel_launch: hipFuncSetAttribute failed\n"); grid = -1; return; }
        if (hipOccupancyMaxActiveBlocksPerMultiprocessor(&per_cu, (const void*)fwd_megakernel, NTHR, LDS_BYTES) != hipSuccess || per_cu < 1) { fprintf(stderr, "kernel_launch: occupancy query gave %d\n", per_cu); per_cu = 1; }
        (void)hipGetLastError();
        grid = cus * per_cu;
        fprintf(stderr, "kernel_launch: grid %d (%d CUs x %d)\n", grid, cus, per_cu);
    }
    if (grid < 0) return;
    Args a{};
    for (int i = 0; i < 17; ++i) a.in[i] = (const float*)d_in[i];
    a.out = (float*)d_out; a.ws = (unsigned char*)d_ws;
#if MK_N_LAUNCHES == 1
    a.ph_lo = 0; a.ph_hi = NPHASE;
    void* kargs[] = {&a};
    hipError_t e = hipLaunchCooperativeKernel((const void*)fwd_megakernel, dim3(grid), dim3(NTHR), kargs, LDS_BYTES, stream);
    if (e != hipSuccess) fprintf(stderr, "kernel_launch: cooperative launch failed: %s (grid %d)\n", hipGetErrorString(e), grid);
#else
    for (int p = 0; p < NPHASE; ++p) {
        a.ph_lo = p; a.ph_hi = p + 1;
        hipLaunchKernelGGL(fwd_megakernel, dim3(grid), dim3(NTHR), LDS_BYTES, stream, a);
    }
#endif
}
```

```cpp
#include <hip/hip_runtime.h>
#include <hip/hip_cooperative_groups.h>
#include <cstdio>
#include <cstdint>
namespace cg = cooperative_groups;
namespace pg8 {
#define PG8_LAS __attribute__((address_space(3)))
typedef unsigned short bf16_t;
typedef short bf16x8 __attribute__((ext_vector_type(8)));
typedef float f32x4 __attribute__((ext_vector_type(4)));
typedef unsigned u32x4 __attribute__((ext_vector_type(4)));
constexpr int BM = 256, BK = 64, HALF = 128, HTB = HALF * BK * 2  , STAGE_BYTES = 8 * HTB, NXCD = 8, WGM = 8;

__host__ __device__ __forceinline__ int lds_byte(int r, int c) { const int st = (r >> 4) * 2 + (c >> 5), rr = r & 15, cc = c & 31, ob = rr * 64 + cc * 2; return st * 1024 + (ob ^ (((ob >> 9) & 1) << 5)); }
__host__ __device__ __forceinline__ void stage_rc(int b, int& R, int& C) { const int st = b / 1024, sb = b % 1024, swz = sb ^ (((sb >> 9) & 1) << 5); R = (st >> 1) * 16 + swz / 64; C = (st & 1) * 32 + (swz % 64) / 2; }
__host__ __device__ __forceinline__ int perm32(int rho) { const int n = rho >> 4, i = rho & 15; return 8 * (i >> 2) + 4 * n + (i & 3); }

struct Unit { int pm, pn; };
struct Gemm { const bf16_t* A; const bf16_t* Bt; int M, N, K, lda, ldb; };

struct StaticOrder {
    int nM, nN, nwg, G, c;
    __host__ __device__ void init(int M, int N, int G_, int c_) { nM = M / BM; nN = N / BM; nwg = nM * nN; G = G_; c = c_; }
    __host__ __device__ bool next(int i, Unit& u) const {
        const long L = (long)i * G + c; if (L >= nwg) return false;
        int wgid = (int)L; { const int q = nwg / NXCD, r = nwg % NXCD, xcd = wgid % NXCD, off = wgid / NXCD; wgid = (xcd < r ? xcd * (q + 1) : r * (q + 1) + (xcd - r) * q) + off; }
        const int nig = WGM * nN, gid = wgid / nig, fm = gid * WGM, gsz = (nM - fm) < WGM ? (nM - fm) : WGM;
        u.pm = fm + ((wgid % nig) % gsz); u.pn = (wgid % nig) / gsz; return true;
    }
    __device__ __forceinline__ void a_ready(const Unit&) const {}
    __device__ __forceinline__ void done(const Unit&) const {}
};

__device__ __forceinline__ unsigned cvt_pk_bf16(float lo, float hi) { unsigned r; asm volatile("v_cvt_pk_bf16_f32 %0, %1, %2" : "=v"(r) : "v"(lo), "v"(hi)); return r; }
typedef float f32x2 __attribute__((ext_vector_type(2)));
__device__ __forceinline__ f32x2 gelu_pk(f32x2 v) {
    const f32x2 av = __builtin_elementwise_abs(v), d = av * 0.2316418882f + 1.0f;
    f32x2 t; t.x = __builtin_amdgcn_rcpf(d.x); t.y = __builtin_amdgcn_rcpf(d.y);
    f32x2 q = t * 0.5307027145f + (-0.7265760135f); q = q * t + 0.7107068705f; q = q * t + (-0.142248368f); q = q * t + 0.127414796f; q = q * t;
    const f32x2 s = (v * v) * (-0.72134752044f);
    f32x2 e; e.x = __builtin_amdgcn_exp2f(s.x); e.y = __builtin_amdgcn_exp2f(s.y);
    const f32x2 m = v * (q * e), r = v - m;
    f32x2 o; o.x = v.x < 0.f ? m.x : r.x; o.y = v.y < 0.f ? m.y : r.y; return o;
}

template <int ACT  > struct EpiBf16 {
    static constexpr bool PERM = true, AFTER_DRAIN = false; static_assert(ACT == 0 || ACT == 1, "EpiBf16: ACT is 0 (none) or 1 (gelu_pk)");
    bf16_t* O; int ldc; const float* bias; int split_cols; size_t split_stride; float scale0;
    __device__ __forceinline__ void operator()(const f32x4 (&acc)[2][2][4][2], const Unit& u, int wr, int wc, int fr, int fq) const {
        const int row0 = u.pm * BM + wr * 64 + fr; int colt = u.pn * BM; bf16_t* base = O;
        float sc = 1.f; if (split_cols) { const int t = colt / split_cols; base += (size_t)t * split_stride; colt -= t * split_cols; if (t == 0) sc = scale0; }
        const int col0 = colt + wc * 32 + 8 * fq, bcol0 = u.pn * BM + wc * 32 + 8 * fq;
        f32x4 bv[2][2];
#pragma unroll
        for (int bj = 0; bj < 2; ++bj)
#pragma unroll
            for (int n = 0; n < 2; ++n) bv[bj][n] = bias ? *(const f32x4*)(bias + bcol0 + bj * HALF + 4 * n) : (f32x4){0.f, 0.f, 0.f, 0.f};
#pragma unroll
        for (int ai = 0; ai < 2; ++ai)
#pragma unroll
            for (int m = 0; m < 4; ++m) { bf16_t* rowp = base + (size_t)(row0 + ai * HALF + m * 16) * ldc + col0;
#pragma unroll
                for (int bj = 0; bj < 2; ++bj) { f32x4 v0 = acc[ai][bj][m][0] + bv[bj][0], v1 = acc[ai][bj][m][1] + bv[bj][1];
                    if (ACT == 1) { f32x2 a = gelu_pk((f32x2){v0[0], v0[1]}), b = gelu_pk((f32x2){v0[2], v0[3]}), c = gelu_pk((f32x2){v1[0], v1[1]}), d = gelu_pk((f32x2){v1[2], v1[3]});
                        v0 = (f32x4){a.x, a.y, b.x, b.y}; v1 = (f32x4){c.x, c.y, d.x, d.y}; }
                    v0 = v0 * sc; v1 = v1 * sc; u32x4 w; w.x = cvt_pk_bf16(v0[0], v0[1]); w.y = cvt_pk_bf16(v0[2], v0[3]); w.z = cvt_pk_bf16(v1[0], v1[1]); w.w = cvt_pk_bf16(v1[2], v1[3]);
                    *(u32x4*)(rowp + bj * HALF) = w; } }
    }
};
template <class Epi, class Sched, bool ALIGN_EPI = false, bool SP2 = false>
__device__ __forceinline__ void gemm_phase(PG8_LAS unsigned char* lds, const Gemm g, const Sched& S, const Epi& E) {
    const int tid = threadIdx.x, wid = __builtin_amdgcn_readfirstlane(tid >> 6), lane = tid & 63, wr = wid >> 2, wc = wid & 3, fr = lane & 15, fq = lane >> 4;
    const int K = g.K, nt = K / BK;
    unsigned voffA[2], voffB[2];
#pragma unroll
    for (int i = 0; i < 2; ++i) { int R, C; stage_rc(tid * 16 + i * 8192, R, C); const int Rb = Epi::PERM ? ((R & ~31) + perm32(R & 31)) : R;
        voffA[i] = (unsigned)(R * g.lda + C) * 2u; voffB[i] = (unsigned)(Rb * g.ldb + C) * 2u; }
    const size_t kstep = (size_t)(BK * 2);
    const size_t hstepA = (size_t)HALF * g.lda * 2, hstepB = (size_t)HALF * g.ldb * 2;
    const size_t tstepA = 2 * hstepA, tstepB = 2 * hstepB;
    const unsigned ldsw = (unsigned)wid * 1024u;
    const int aoff = lds_byte(wr * 64 + fr, fq * 8), boff = lds_byte(wc * 32 + fr, fq * 8);
#define PG8_SA(b, h) (((b) * 2 + (h)) * HTB)
#define PG8_SB(b, h) ((4 + (b) * 2 + (h)) * HTB)
#define PG8_STAGE(bufoff, gbase, voff) do { _Pragma("unroll") for (int _i = 0; _i < 2; ++_i) \
        __builtin_amdgcn_global_load_lds((const unsigned*)((const char*)(gbase) + (voff)[_i]), (PG8_LAS unsigned*)(lds + (bufoff) + ldsw + _i * 8192), 16, 0, 0); } while (0)
#define PG8_LDA(dst, b, h) do { _Pragma("unroll") for (int m = 0; m < 4; ++m) _Pragma("unroll") for (int k = 0; k < 2; ++k) dst[m][k] = *(const PG8_LAS bf16x8*)(lds + PG8_SA(b, h) + aoff + m * 2048 + k * 1024); } while (0)
#define PG8_LDB(dst, b, h) do { _Pragma("unroll") for (int n = 0; n < 2; ++n) _Pragma("unroll") for (int k = 0; k < 2; ++k) dst[n][k] = *(const PG8_LAS bf16x8*)(lds + PG8_SB(b, h) + boff + n * 2048 + k * 1024); } while (0)
#define PG8_MMA(ai, bj, At, Bt) do { __builtin_amdgcn_s_setprio(1); _Pragma("unroll") for (int m = 0; m < 4; ++m) _Pragma("unroll") for (int n = 0; n < 2; ++n) _Pragma("unroll") for (int k = 0; k < 2; ++k) \
        acc[ai][bj][m][n] = __builtin_amdgcn_mfma_f32_16x16x32_bf16(Bt[n][k], At[m][k], acc[ai][bj][m][n], 0, 0, 0); __builtin_amdgcn_s_setprio(0); } while (0)
#define PG8_WAIT_V(n) asm volatile("s_waitcnt vmcnt(" #n ")" ::: "memory")
#define PG8_WAIT_L(n) asm volatile("s_waitcnt lgkmcnt(" #n ")" ::: "memory")
#define PG8_BAR __builtin_amdgcn_s_barrier()
#define PG8_SCHED __builtin_amdgcn_sched_barrier(0)
    Unit cur, nxt; int ui = 0;
    if (!S.next(0, cur)) return;
    f32x4 acc[2][2][4][2];
#pragma unroll
    for (int a = 0; a < 2; ++a)
#pragma unroll
        for (int b = 0; b < 2; ++b)
#pragma unroll
            for (int m = 0; m < 4; ++m)
#pragma unroll
                for (int n = 0; n < 2; ++n) acc[a][b][m][n] = (f32x4){0.f, 0.f, 0.f, 0.f};
    bf16x8 At[4][2], B0[2][2], B1[2][2];
    const char* cA = (const char*)g.A + (size_t)cur.pm * tstepA; const char* cB = (const char*)g.Bt + (size_t)cur.pn * tstepB;
    S.a_ready(cur);
    if constexpr (SP2) {
        PG8_STAGE(PG8_SB(0, 0), cB, voffB); PG8_STAGE(PG8_SB(0, 1), cB + hstepB, voffB); PG8_STAGE(PG8_SA(0, 0), cA, voffA); PG8_STAGE(PG8_SA(0, 1), cA + hstepA, voffA);
        if (wr == 1) PG8_BAR;
        PG8_WAIT_V(2); PG8_BAR;
        PG8_STAGE(PG8_SB(1, 0), cB + kstep, voffB); PG8_STAGE(PG8_SA(1, 0), cA + kstep, voffA); PG8_STAGE(PG8_SB(1, 1), cB + hstepB + kstep, voffB);
        PG8_WAIT_V(6); PG8_BAR;
    } else {
        PG8_STAGE(PG8_SB(0, 0), cB, voffB); PG8_STAGE(PG8_SA(0, 0), cA, voffA); PG8_STAGE(PG8_SB(0, 1), cB + hstepB, voffB); PG8_STAGE(PG8_SA(0, 1), cA + hstepA, voffA);
        if (wr == 1) PG8_BAR;
        PG8_WAIT_V(4); PG8_BAR;
        PG8_STAGE(PG8_SB(1, 0), cB + kstep, voffB); PG8_STAGE(PG8_SA(1, 0), cA + kstep, voffA); PG8_STAGE(PG8_SB(1, 1), cB + hstepB + kstep, voffB);
        PG8_WAIT_V(6); PG8_BAR;
    }
    for (;;) {
        const bool has_next = S.next(ui + 1, nxt);
        const char* nA = has_next ? (const char*)g.A + (size_t)nxt.pm * tstepA : cA; const char* nB = has_next ? (const char*)g.Bt + (size_t)nxt.pn * tstepB : cB;
        for (int t = 0; t < nt; t += 2) {
            const bool last = (t == nt - 2);
            const char* a1 = cA + (size_t)(t + 1) * kstep;
            const char* a2 = last ? nA : cA + (size_t)(t + 2) * kstep; const char* b2 = last ? nB : cB + (size_t)(t + 2) * kstep;
            const char* a3 = a2 + kstep; const char* b3 = b2 + kstep;
            if (last && has_next) S.a_ready(nxt);
            if constexpr (SP2) {
            PG8_LDB(B0, 0, 0); PG8_LDB(B1, 0, 1); PG8_SCHED; PG8_LDA(At, 0, 0); PG8_STAGE(PG8_SA(1, 1), a1 + hstepA, voffA);
            PG8_WAIT_V(8); PG8_WAIT_L(0); PG8_BAR; PG8_MMA(0, 0, At, B0); PG8_MMA(0, 1, At, B1); PG8_BAR; PG8_SCHED;
            PG8_LDA(At, 0, 1); PG8_STAGE(PG8_SB(0, 0), b2, voffB); PG8_STAGE(PG8_SB(0, 1), b2 + hstepB, voffB); PG8_STAGE(PG8_SA(0, 0), a2, voffA);
            PG8_WAIT_V(8); PG8_WAIT_L(0); PG8_BAR; PG8_MMA(1, 0, At, B0); PG8_MMA(1, 1, At, B1); PG8_BAR; PG8_SCHED;
            PG8_LDB(B0, 1, 0); PG8_LDB(B1, 1, 1); PG8_SCHED; PG8_LDA(At, 1, 0); PG8_STAGE(PG8_SA(0, 1), a2 + hstepA, voffA);
            PG8_WAIT_V(8); PG8_WAIT_L(0); PG8_BAR; PG8_MMA(0, 0, At, B0); PG8_MMA(0, 1, At, B1); PG8_BAR; PG8_SCHED;
            PG8_LDA(At, 1, 1); PG8_STAGE(PG8_SB(1, 0), b3, voffB); PG8_STAGE(PG8_SB(1, 1), b3 + hstepB, voffB); PG8_STAGE(PG8_SA(1, 0), a3, voffA);
            PG8_WAIT_V(8); PG8_WAIT_L(0); PG8_BAR; PG8_MMA(1, 0, At, B0); PG8_MMA(1, 1, At, B1); PG8_BAR; PG8_SCHED;
            } else {
            PG8_LDB(B0, 0, 0); PG8_SCHED; PG8_LDA(At, 0, 0); PG8_STAGE(PG8_SA(1, 1), a1 + hstepA, voffA);
            PG8_WAIT_L(8); PG8_BAR; PG8_WAIT_L(0); PG8_MMA(0, 0, At, B0); PG8_BAR; PG8_SCHED;
            PG8_LDB(B1, 0, 1); PG8_STAGE(PG8_SB(0, 0), b2, voffB);
            PG8_BAR; PG8_WAIT_L(0); PG8_MMA(0, 1, At, B1); PG8_BAR;
            PG8_LDA(At, 0, 1); PG8_STAGE(PG8_SA(0, 0), a2, voffA);
            PG8_BAR; PG8_WAIT_L(0); PG8_MMA(1, 0, At, B0); PG8_BAR; PG8_SCHED;
            PG8_STAGE(PG8_SB(0, 1), b2 + hstepB, voffB);
            PG8_WAIT_V(6); PG8_BAR; PG8_MMA(1, 1, At, B1); PG8_BAR;
            PG8_LDB(B0, 1, 0); PG8_SCHED; PG8_LDA(At, 1, 0); PG8_STAGE(PG8_SA(0, 1), a2 + hstepA, voffA);
            PG8_WAIT_L(8); PG8_BAR; PG8_WAIT_L(0); PG8_MMA(0, 0, At, B0); PG8_BAR; PG8_SCHED;
            PG8_LDB(B1, 1, 1); PG8_STAGE(PG8_SB(1, 0), b3, voffB);
            PG8_BAR; PG8_WAIT_L(0); PG8_MMA(0, 1, At, B1); PG8_BAR;
            PG8_LDA(At, 1, 1); PG8_STAGE(PG8_SA(1, 0), a3, voffA);
            PG8_BAR; PG8_WAIT_L(0); PG8_MMA(1, 0, At, B0); PG8_BAR; PG8_SCHED;
            PG8_STAGE(PG8_SB(1, 1), b3 + hstepB, voffB);
            PG8_WAIT_V(6); PG8_BAR; PG8_MMA(1, 1, At, B1); PG8_BAR;
            }
        }
        if constexpr (ALIGN_EPI) { if (wr == 0) PG8_BAR; }
        if constexpr (!Epi::AFTER_DRAIN) { E(acc, cur, wr, wc, fr, fq); S.done(cur); }
        if (!has_next) break;
#pragma unroll
        for (int a = 0; a < 2; ++a)
#pragma unroll
            for (int b = 0; b < 2; ++b)
#pragma unroll
                for (int m = 0; m < 4; ++m)
#pragma unroll
                    for (int n = 0; n < 2; ++n) acc[a][b][m][n] = (f32x4){0.f, 0.f, 0.f, 0.f};
        cur = nxt; cA = nA; cB = nB; ++ui;
        if constexpr (ALIGN_EPI) { if (wr == 1) PG8_BAR; }
    }
    PG8_WAIT_V(0);
    if constexpr (!ALIGN_EPI) { if (wr == 0) PG8_BAR; }
    PG8_BAR;
    if constexpr (Epi::AFTER_DRAIN) { E.fused(acc, cur, wr, wc, fr, fq, lds, wid, lane); S.done(cur); }
#undef PG8_SA
#undef PG8_SB
#undef PG8_STAGE
#undef PG8_LDA
#undef PG8_LDB
#undef PG8_MMA
#undef PG8_WAIT_V
#undef PG8_WAIT_L
#undef PG8_BAR
#undef PG8_SCHED
}
}

#ifndef MK_N_LAUNCHES
#define MK_N_LAUNCHES 1
#endif
constexpr int NWAVES = 8, NTHR = 512, NPHASE = 8;
constexpr int BATCH = 2, T = 8192, D = 1024, M = BATCH * T;
constexpr int DPROJ = 5664, DMIX = 2048;
constexpr int NPN = 3840, NPT = 2048, NWT = NPN + NPT;
constexpr int CN_G = 0, CN_Z = 1024, CN_Q = 2048, CN_K = 2560, CN_B = 3072, CN_C = 3328, CN_GL = 3584, CN_DT = 3600, CN_PAD = 3616;
constexpr float EPS = 1e-6f;
constexpr size_t MiB = 1u << 20;
constexpr size_t WS_ADA = 0, WS_SDEC = 32 * 1024, WS_GDEC = 64 * 1024;
constexpr size_t WS_WOUT = 1 * MiB, WS_WT = 5 * MiB, WS_H = 17 * MiB, WS_PN = 49 * MiB, WS_PT = 169 * MiB, WS_END = 233 * MiB;
constexpr size_t WS_SS = 5 * MiB;
constexpr int LDS_BYTES = 147456;

#define LAS __attribute__((address_space(3)))
typedef unsigned short bf16_t;
typedef short bf16x8 __attribute__((ext_vector_type(8)));
typedef float f32x4 __attribute__((ext_vector_type(4)));
typedef float f32x2 __attribute__((ext_vector_type(2)));
typedef unsigned u32x4 __attribute__((ext_vector_type(4)));
typedef unsigned u32x2 __attribute__((ext_vector_type(2)));
#define LDS_WAIT() asm volatile("s_waitcnt lgkmcnt(0)" ::: "memory")

__device__ __forceinline__ float bf2f(unsigned b) { return __uint_as_float(b << 16); }
__device__ __forceinline__ float bflo(unsigned u) { return __uint_as_float(u << 16); }
__device__ __forceinline__ float bfhi(unsigned u) { return __uint_as_float(u & 0xffff0000u); }
typedef __bf16 bf16x2_t __attribute__((ext_vector_type(2)));
__device__ __forceinline__ unsigned pk2(float lo, float hi) { const f32x2 v = {lo, hi}; const bf16x2_t b = __builtin_convertvector(v, bf16x2_t); return __builtin_bit_cast(unsigned, b); }
__device__ __forceinline__ bf16_t f2bf(float f) { const __bf16 b = (__bf16)f; return __builtin_bit_cast(unsigned short, b); }
__device__ __forceinline__ void st_wt8(void* p, u32x2 v) { __hip_atomic_store((unsigned long long*)p, ((unsigned long long)v.y << 32) | v.x, __ATOMIC_RELAXED, __HIP_MEMORY_SCOPE_AGENT); }
__device__ __forceinline__ void st_wt4(void* p, unsigned v) { __hip_atomic_store((unsigned*)p, v, __ATOMIC_RELAXED, __HIP_MEMORY_SCOPE_AGENT); }
__device__ __forceinline__ float silu_f(float x) { return x * __builtin_amdgcn_rcpf(1.f + __expf(-x)); }
__device__ __forceinline__ float wave_sum(float v) {
#pragma unroll
    for (int o = 1; o < 64; o <<= 1) v += __shfl_xor(v, o);
    return v;
}
__device__ __forceinline__ f32x4 mma16(bf16x8 arow, bf16x8 brow, f32x4 acc) { return __builtin_amdgcn_mfma_f32_16x16x32_bf16(brow, arow, acc, 0, 0, 0); }
__device__ __forceinline__ bf16x8 lfrag(const LAS bf16_t* base, int row, int pitch, int k) { return *(const LAS bf16x8*)(base + row * pitch + k); }
__device__ __forceinline__ bf16x8 gfrag(const bf16_t* p) { return *(const bf16x8*)p; }

__device__ __forceinline__ bf16_t* sg_item(unsigned char* sg, int item) { return (bf16_t*)sg + (size_t)item * 32768; }
__device__ __forceinline__ int win_dest(int n) {
    if (n < 512) return CN_Q + n;
    if (n < 1024) return CN_K + (n - 512);
    if (n < 2048) return NPN + (n - 1024);
    if (n < 3072) return CN_G + (n - 2048);
    if (n < 3088) return CN_GL + (n - 3072);
    if (n < 4112) return CN_Z + (n - 3088);
    if (n < 5136) return NPN + 1024 + (n - 4112);
    if (n < 5392) return CN_B + (n - 5136);
    if (n < 5648) return CN_C + (n - 5392);
    return CN_DT + (n - 5648);
}

template <bool WIN>
__device__ __forceinline__ void transpose_item(const float* __restrict__ W, int K, int N, bf16_t* __restrict__ WT, LAS float* scr, int item, int lane) {
    const int nblk = N / 32, kb = item / nblk, nb = item % nblk, k0 = 64 * kb, n0 = 32 * nb;
#pragma unroll 8
    for (int i = 0; i < 32; ++i) { const int kk = 2 * i + (lane >> 5); scr[kk * 33 + (lane & 31)] = W[(size_t)(k0 + kk) * N + n0 + (lane & 31)]; }
    LDS_WAIT();
    const int c = lane & 7;
#pragma unroll
    for (int j = 0; j < 4; ++j) {
        const int n = (lane >> 3) + 8 * j; const LAS float* s = scr + (8 * c) * 33 + n;
        u32x4 o; o.x = pk2(s[0 * 33], s[1 * 33]); o.y = pk2(s[2 * 33], s[3 * 33]); o.z = pk2(s[4 * 33], s[5 * 33]); o.w = pk2(s[6 * 33], s[7 * 33]);
        const int dr = WIN ? win_dest(n0 + n) : (n0 + n);
        *(u32x4*)(WT + (size_t)dr * K + k0 + 8 * c) = o;
    }
    LDS_WAIT();
}

__device__ __forceinline__ void phase0(LAS unsigned char* lds, const float* __restrict__ c_in, const float* __restrict__ ada_w, const float* __restrict__ ada_b,
                                       const float* __restrict__ w_in, const float* __restrict__ w_out, unsigned char* ws, int tid, int wave, int lane) {
    bf16_t* WT = (bf16_t*)(ws + WS_WT); bf16_t* WOT = (bf16_t*)(ws + WS_WOUT); float* ada = (float*)(ws + WS_ADA);
    const int G = gridDim.x;
    for (int it = blockIdx.x; it < 192; it += G) {
        LAS float* red = (LAS float*)(lds + 8 * 16384);
        const int n0 = 16 * it, kk = lane >> 4, nn = lane & 15;
        float a0 = 0.f, a1 = 0.f;
#pragma unroll 8
        for (int i = 0; i < 32; ++i) {
            const int k = 128 * wave + 4 * i + kk;
            const float wv = ada_w[(size_t)k * 3072 + n0 + nn];
            a0 += silu_f(c_in[k]) * wv; a1 += silu_f(c_in[D + k]) * wv;
        }
        a0 += __shfl_xor(a0, 16); a0 += __shfl_xor(a0, 32); a1 += __shfl_xor(a1, 16); a1 += __shfl_xor(a1, 32);
        if (lane < 16) { red[(wave * 2 + 0) * 16 + nn] = a0; red[(wave * 2 + 1) * 16 + nn] = a1; }
        __syncthreads();
        if (tid < 32) { const int b = tid >> 4, n = tid & 15; float s = ada_b[n0 + n];
#pragma unroll
            for (int w = 0; w < 8; ++w) s += red[(w * 2 + b) * 16 + n];
            ada[b * 3072 + n0 + n] = s; }
        __syncthreads();
    }
    LAS float* scr = (LAS float*)(lds + wave * 16384);
    const int gw = blockIdx.x * NWAVES + wave, NGW = G * NWAVES;
    constexpr int I_IN = (D / 64) * (DPROJ / 32), I_OUT = (DMIX / 64) * (D / 32);
    for (int it = gw; it < I_IN + I_OUT; it += NGW) {
        if (it < I_IN) transpose_item<true>(w_in, D, DPROJ, WT, scr, it, lane);
        else transpose_item<false>(w_out, DMIX, D, WOT, scr, it - I_IN, lane);
    }
#ifdef POISON_SS
    { const int gt = blockIdx.x * NTHR + tid, GT = G * NTHR; u32x4* z = (u32x4*)(ws + POISON_SS);
      for (int i = gt; i < (int)(32 * MiB / 16); i += GT) z[i] = (u32x4){0x7fc07fc0u, 0x7fc07fc0u, 0x7fc07fc0u, 0x7fc07fc0u}; }
#endif
    { const int gt = blockIdx.x * NTHR + tid, GT = G * NTHR; u32x4* z = (u32x4*)(WT + (size_t)CN_PAD * D);
      for (int i = gt; i < (NPN - CN_PAD) * D / 8; i += GT) z[i] = (u32x4){0u, 0u, 0u, 0u}; }
}

__device__ __forceinline__ void phase1(const float* __restrict__ x, const float* __restrict__ pre_w, const unsigned char* ws_c, bf16_t* __restrict__ H, int wave, int lane) {
    const float* ada = (const float*)(ws_c + WS_ADA);
    const int gw = blockIdx.x * NWAVES + wave, NGW = gridDim.x * NWAVES;
    for (int m = gw; m < M; m += NGW) {
        const int b = m >> 13;
        const f32x4* xr = (const f32x4*)(x + (size_t)m * D) + lane;
        f32x4 v[4]; float s = 0.f;
#pragma unroll
        for (int j = 0; j < 4; ++j) { v[j] = xr[64 * j]; s += (v[j].x * v[j].x + v[j].y * v[j].y) + (v[j].z * v[j].z + v[j].w * v[j].w); }
        const float rstd = rsqrtf(wave_sum(s) * (1.f / D) + EPS);
        unsigned long long* o8 = (unsigned long long*)(H + (size_t)m * D) + lane;
#pragma unroll
        for (int j = 0; j < 4; ++j) {
            const int col = 4 * lane + 256 * j;
            const f32x4 w = *(const f32x4*)(pre_w + col), sh = *(const f32x4*)(ada + b * 3072 + col), sc = *(const f32x4*)(ada + b * 3072 + 1024 + col);
            const f32x4 hv = (v[j] * rstd) * w * (sc + 1.f) + sh;
            o8[64 * j] = (unsigned long long)pk2(hv.x, hv.y) | ((unsigned long long)pk2(hv.z, hv.w) << 32);
        }
    }
}

constexpr int GL_OFF_GLR = 0, GL_OFF_PART = 4096, GL_OFF_RED = 6144, GL_OFF_A = 8192, GL_OFF_B = 26624, GL_OFF_ATT = 44032;
template <int MODE>
__device__ __forceinline__ void gla_prep(LAS unsigned char* lds, const bf16_t* __restrict__ PN, const float* __restrict__ w2, const float* __restrict__ gbias, float* gdec, int t0, int h, int tid) {
    LAS float* glr = (LAS float*)(lds + GL_OFF_GLR);
    LAS float* part = (LAS float*)(lds + GL_OFF_PART);
    for (int idx = tid; idx < 1024; idx += NTHR) glr[idx] = bf2f(PN[(size_t)(t0 + (idx >> 4)) * NPN + CN_GL + (idx & 15)]);
    const int k = tid & 127, jq = tid >> 7;
    float w[16];
#pragma unroll
    for (int r = 0; r < 16; ++r) w[r] = w2[r * 512 + h * 128 + k];
    const float bias = gbias[h * 128 + k];
    __syncthreads();
    float pre[16]; float run = 0.f;
#pragma unroll
    for (int jj = 0; jj < 16; ++jj) {
        const LAS f32x4* g4 = (const LAS f32x4*)(glr + (jq * 16 + jj) * 16);
        float xg = bias;
#pragma unroll
        for (int r4 = 0; r4 < 4; ++r4) { const f32x4 gv = g4[r4]; xg += gv.x * w[4 * r4]; xg += gv.y * w[4 * r4 + 1]; xg += gv.z * w[4 * r4 + 2]; xg += gv.w * w[4 * r4 + 3]; }
        const float ls = fminf(xg, 0.f) - __logf(1.f + __expf(-fabsf(xg)));
        run += ls * (1.f / 16.f);
        pre[jj] = run;
    }
    part[jq * 128 + k] = run;
    __syncthreads();
    float off = 0.f, tot = 0.f;
#pragma unroll
    for (int q = 0; q < 4; ++q) { const float p = part[q * 128 + k]; off += (q < jq) ? p : 0.f; tot += p; }
    if (MODE == 0) {
        LAS bf16_t* KeT = (LAS bf16_t*)(lds + GL_OFF_A);
        const bf16_t* kp = PN + (size_t)(t0 + jq * 16) * NPN + CN_K + h * 128 + k;
#pragma unroll
        for (int jj = 0; jj < 16; jj += 2) {
            const float k0 = bf2f(kp[(size_t)jj * NPN]), k1 = bf2f(kp[(size_t)(jj + 1) * NPN]);
            const float e0 = __expf(tot - (off + pre[jj])), e1 = __expf(tot - (off + pre[jj + 1]));
            *(LAS unsigned*)(KeT + k * 72 + jq * 16 + jj) = pk2(k0 * e0, k1 * e1);
        }
        if (jq == 0) gdec[k] = __expf(tot);
    } else {
        LAS bf16_t* Qd = (LAS bf16_t*)(lds + GL_OFF_A); LAS bf16_t* Kd = (LAS bf16_t*)(lds + GL_OFF_B);
        const bf16_t* qp = PN + (size_t)(t0 + jq * 16) * NPN + CN_Q + h * 128 + k;
        const bf16_t* kp = PN + (size_t)(t0 + jq * 16) * NPN + CN_K + h * 128 + k;
#pragma unroll
        for (int jj = 0; jj < 16; ++jj) {
            const float bb = off + pre[jj];
            const float qv = bf2f(qp[(size_t)jj * NPN]) * 0.08838834764831845f * __expf(bb);
            const float kv = bf2f(kp[(size_t)jj * NPN]) * __expf(-bb);
            Qd[(jq * 16 + jj) * 136 + k] = f2bf(qv); Kd[(jq * 16 + jj) * 136 + k] = f2bf(kv);
        }
    }
}

__device__ __forceinline__ void gla_state_item(LAS unsigned char* lds, const bf16_t* __restrict__ PN, const bf16_t* __restrict__ PT, const float* __restrict__ w2, const float* __restrict__ gbias,
                                               float* gdec, unsigned char* ws, int item, int tid, int wave, int lane) {
    const int h = item & 3, t0 = (item >> 2) * 64;
    gla_prep<0>(lds, PN, w2, gbias, gdec + (size_t)item * 128, t0, h, tid);
    const int fr = lane & 15, fq = lane >> 4;
    bf16x8 av[2][2];
#pragma unroll
    for (int mt = 0; mt < 2; ++mt)
#pragma unroll
        for (int ks = 0; ks < 2; ++ks) av[mt][ks] = gfrag(PT + (size_t)(h * 256 + wave * 32 + mt * 16 + fr) * M + t0 + ks * 32 + 8 * fq);
    __syncthreads();
    const LAS bf16_t* KeT = (const LAS bf16_t*)(lds + GL_OFF_A);
    f32x4 acc[2][8];
#pragma unroll
    for (int mt = 0; mt < 2; ++mt)
#pragma unroll
        for (int nt = 0; nt < 8; ++nt) acc[mt][nt] = (f32x4){0.f, 0.f, 0.f, 0.f};
#pragma unroll
    for (int nt = 0; nt < 8; ++nt)
#pragma unroll
        for (int ks = 0; ks < 2; ++ks) {
            const bf16x8 bfg = lfrag(KeT, nt * 16 + fr, 72, ks * 32 + 8 * fq);
#pragma unroll
            for (int mt = 0; mt < 2; ++mt) acc[mt][nt] = mma16(av[mt][ks], bfg, acc[mt][nt]);
        }
    bf16_t* So = sg_item(ws, item);
#pragma unroll
    for (int mt = 0; mt < 2; ++mt)
#pragma unroll
        for (int nt = 0; nt < 8; ++nt) {
            const int v = wave * 32 + mt * 16 + fr, kk = nt * 16 + 4 * fq;
            u32x2 o; o.x = pk2(acc[mt][nt][0], acc[mt][nt][1]); o.y = pk2(acc[mt][nt][2], acc[mt][nt][3]);
            *(u32x2*)(So + v * 128 + kk) = o;
        }
    __syncthreads();
}

__device__ __forceinline__ void gla_out_item(LAS unsigned char* lds, bf16_t* __restrict__ PN, const bf16_t* __restrict__ PT, const float* __restrict__ w2, const float* __restrict__ gbias,
                                             const float* __restrict__ gnw, unsigned char* ws, int item, int tid, int wave, int lane) {
    const int h = item & 3, t0 = (item >> 2) * 64;
    gla_prep<1>(lds, PN, w2, gbias, nullptr, t0, h, tid);
    __syncthreads();
    const int fr = lane & 15, fq = lane >> 4;
    const LAS bf16_t* Qd = (const LAS bf16_t*)(lds + GL_OFF_A); const LAS bf16_t* Kd = (const LAS bf16_t*)(lds + GL_OFF_B);
    LAS bf16_t* att = (LAS bf16_t*)(lds + GL_OFF_ATT);
    {
        const int mt = wave >> 1;
#pragma unroll
        for (int e = 0; e < 2; ++e) {
            const int nt = (wave & 1) * 2 + e;
            f32x4 a = (f32x4){0.f, 0.f, 0.f, 0.f};
            if (nt <= mt) {
#pragma unroll
                for (int ks = 0; ks < 4; ++ks) a = mma16(lfrag(Qd, mt * 16 + fr, 136, ks * 32 + 8 * fq), lfrag(Kd, nt * 16 + fr, 136, ks * 32 + 8 * fq), a);
            }
            const int i = mt * 16 + fr, j0 = nt * 16 + 4 * fq;
            const float v0 = (j0 + 0 <= i) ? a[0] : 0.f, v1 = (j0 + 1 <= i) ? a[1] : 0.f, v2 = (j0 + 2 <= i) ? a[2] : 0.f, v3 = (j0 + 3 <= i) ? a[3] : 0.f;
            u32x2 o; o.x = pk2(v0, v1); o.y = pk2(v2, v3);
            *(LAS u32x2*)(att + i * 72 + j0) = o;
        }
    }
    __syncthreads();
    f32x4 acc[4][2];
#pragma unroll
    for (int mt = 0; mt < 4; ++mt)
#pragma unroll
        for (int nt = 0; nt < 2; ++nt) acc[mt][nt] = (f32x4){0.f, 0.f, 0.f, 0.f};
#pragma unroll
    for (int ks = 0; ks < 2; ++ks) {
        bf16x8 bv[2];
#pragma unroll
        for (int nt = 0; nt < 2; ++nt) bv[nt] = gfrag(PT + (size_t)(h * 256 + wave * 32 + nt * 16 + fr) * M + t0 + ks * 32 + 8 * fq);
#pragma unroll
        for (int mt = 0; mt < 4; ++mt) {
            if (ks == 1 && mt < 2) continue;
            const bf16x8 af = lfrag(att, mt * 16 + fr, 72, ks * 32 + 8 * fq);
#pragma unroll
            for (int nt = 0; nt < 2; ++nt) acc[mt][nt] = mma16(af, bv[nt], acc[mt][nt]);
        }
    }
    const bf16_t* Sp = sg_item(ws, item);
#pragma unroll
    for (int ks = 0; ks < 4; ++ks) {
        bf16x8 bs[2];
#pragma unroll
        for (int nt = 0; nt < 2; ++nt) bs[nt] = gfrag(Sp + (wave * 32 + nt * 16 + fr) * 128 + ks * 32 + 8 * fq);
#pragma unroll
        for (int mt = 0; mt < 4; ++mt) {
            const bf16x8 af = lfrag(Qd, mt * 16 + fr, 136, ks * 32 + 8 * fq);
#pragma unroll
            for (int nt = 0; nt < 2; ++nt) acc[mt][nt] = mma16(af, bs[nt], acc[mt][nt]);
        }
    }
    LAS float* red = (LAS float*)(lds + GL_OFF_RED);
#pragma unroll
    for (int mt = 0; mt < 4; ++mt) {
        float s = 0.f;
#pragma unroll
        for (int nt = 0; nt < 2; ++nt) { const f32x4 a = acc[mt][nt]; s += (a[0] * a[0] + a[1] * a[1]) + (a[2] * a[2] + a[3] * a[3]); }
        s += __shfl_xor(s, 16); s += __shfl_xor(s, 32);
        if (fq == 0) red[wave * 64 + mt * 16 + fr] = s;
    }
    __syncthreads();
#pragma unroll
    for (int mt = 0; mt < 4; ++mt) {
        const int i = mt * 16 + fr;
        float tot = 0.f;
#pragma unroll
        for (int w = 0; w < 8; ++w) tot += red[w * 64 + i];
        const float rstd = rsqrtf(tot * (1.f / 256.f) + EPS);
#pragma unroll
        for (int nt = 0; nt < 2; ++nt) {
            const int v0 = wave * 32 + nt * 16 + 4 * fq;
            const f32x4 nw = *(const f32x4*)(gnw + v0);
            bf16_t* gp = PN + (size_t)(t0 + i) * NPN + CN_G + h * 256 + v0;
            const u32x2 gr = *(const u32x2*)gp;
            const f32x4 a = acc[mt][nt];
            u32x2 o;
            o.x = pk2(a[0] * rstd * nw[0] * silu_f(bflo(gr.x)), a[1] * rstd * nw[1] * silu_f(bfhi(gr.x)));
            o.y = pk2(a[2] * rstd * nw[2] * silu_f(bflo(gr.y)), a[3] * rstd * nw[3] * silu_f(bfhi(gr.y)));
            *(u32x2*)gp = o;
        }
    }
    __syncthreads();
}

constexpr int SS_OFF_DT = 0, SS_OFF_AC = 4096;
constexpr int S3_OFF_BT = 8192, S3_OFF_XT = 43008;
constexpr int S5_OFF_CN = 8192, S5_OFF_BN = 43008, S5_OFF_WH = 77824, S5_OFF_XT = 112640;

__device__ __forceinline__ void ssd_dt_prep(LAS unsigned char* lds, const bf16_t* __restrict__ PN, const float* __restrict__ dt_bias, const float* __restrict__ a_log, int t0, int g, int tid, int wave, int lane) {
    LAS float* dtL = (LAS float*)(lds + SS_OFF_DT); LAS float* acL = (LAS float*)(lds + SS_OFF_AC);
    const int j = tid & 127, hq = tid >> 7;
#pragma unroll
    for (int e = 0; e < 2; ++e) {
        const int hh = hq * 2 + e, hd = g * 8 + hh;
        const float raw = bf2f(PN[(size_t)(t0 + j) * NPN + CN_DT + hd]) + dt_bias[hd];
        const float dt = raw > 20.f ? raw : log1pf(__expf(raw));
        dtL[hh * 128 + j] = dt; acL[hh * 128 + j] = -dt * __expf(a_log[hd]);
    }
    __syncthreads();
    {
        const float v0 = acL[wave * 128 + 2 * lane], v1 = acL[wave * 128 + 2 * lane + 1];
        float s = v0 + v1;
#pragma unroll
        for (int o = 1; o < 64; o <<= 1) { const float t = __shfl_up(s, o); s += (lane >= o) ? t : 0.f; }
        const float ex = s - (v0 + v1);
        acL[wave * 128 + 2 * lane] = ex + v0; acL[wave * 128 + 2 * lane + 1] = ex + v0 + v1;
    }
    __syncthreads();
}
__device__ __forceinline__ void conv8_nat(const bf16_t* __restrict__ PN, const float* __restrict__ cw, const float* __restrict__ cb, int tok, int pos, int col, int ch0, float (&out)[8]) {
    { const f32x4 b0 = *(const f32x4*)(cb + ch0), b1 = *(const f32x4*)(cb + ch0 + 4);
      out[0] = b0[0]; out[1] = b0[1]; out[2] = b0[2]; out[3] = b0[3]; out[4] = b1[0]; out[5] = b1[1]; out[6] = b1[2]; out[7] = b1[3]; }
#pragma unroll
    for (int tp = 0; tp < 4; ++tp) {
        {
            const bool ok = (pos - 3 + tp) >= 0;
            u32x4 raw = *(const u32x4*)(PN + (size_t)(ok ? tok - 3 + tp : tok) * NPN + col);
            raw.x = ok ? raw.x : 0u; raw.y = ok ? raw.y : 0u; raw.z = ok ? raw.z : 0u; raw.w = ok ? raw.w : 0u;
            const f32x4 w0 = *(const f32x4*)(cw + tp * 1536 + ch0), w1 = *(const f32x4*)(cw + tp * 1536 + ch0 + 4);
            out[0] += w0[0] * bflo(raw.x); out[1] += w0[1] * bfhi(raw.x); out[2] += w0[2] * bflo(raw.y); out[3] += w0[3] * bfhi(raw.y);
            out[4] += w1[0] * bflo(raw.z); out[5] += w1[1] * bfhi(raw.z); out[6] += w1[2] * bflo(raw.w); out[7] += w1[3] * bfhi(raw.w);
        }
    }
#pragma unroll
    for (int e = 0; e < 8; ++e) out[e] = silu_f(out[e]);
}
__device__ __forceinline__ void conv8_tr(const bf16_t* __restrict__ PT, const float* __restrict__ cw, const float* __restrict__ cb, int row, int tcol, bool has_prev, int ch, float (&out)[8]) {
    const u32x4 cur = *(const u32x4*)(PT + (size_t)row * M + tcol);
    u32x4 prv = *(const u32x4*)(PT + (size_t)row * M + tcol - (has_prev ? 8 : 0));
    prv.z = has_prev ? prv.z : 0u; prv.w = has_prev ? prv.w : 0u;
    float u[11];
    u[0] = bfhi(prv.z); u[1] = bflo(prv.w); u[2] = bfhi(prv.w);
    u[3] = bflo(cur.x); u[4] = bfhi(cur.x); u[5] = bflo(cur.y); u[6] = bfhi(cur.y); u[7] = bflo(cur.z); u[8] = bfhi(cur.z); u[9] = bflo(cur.w); u[10] = bfhi(cur.w);
    const float w0 = cw[ch], w1 = cw[1536 + ch], w2 = cw[2 * 1536 + ch], w3 = cw[3 * 1536 + ch], bias = cb[ch];
#pragma unroll
    for (int e = 0; e < 8; ++e) out[e] = silu_f(bias + w0 * u[e] + w1 * u[e + 1] + w2 * u[e + 2] + w3 * u[e + 3]);
}

__device__ __forceinline__ void ssd_state_item(LAS unsigned char* lds, const bf16_t* __restrict__ PN, const bf16_t* __restrict__ PT, const float* __restrict__ cw, const float* __restrict__ cb,
                                               const float* __restrict__ dt_bias, const float* __restrict__ a_log, float* sdec, bf16_t* SS, int item, int tid, int wave, int lane) {
    const int g = item & 1, bc = item >> 1, c = bc & 63, t0 = bc * 128;
    ssd_dt_prep(lds, PN, dt_bias, a_log, t0, g, tid, wave, lane);
    const LAS float* dtL = (const LAS float*)(lds + SS_OFF_DT); const LAS float* acL = (const LAS float*)(lds + SS_OFF_AC);
    LAS bf16_t* BT = (LAS bf16_t*)(lds + S3_OFF_BT); LAS bf16_t* XT = (LAS bf16_t*)(lds + S3_OFF_XT);
    for (int idx = tid; idx < 2048; idx += NTHR) {
        const int j = idx & 127, cc = idx >> 7;
        float o[8];
        conv8_nat(PN, cw, cb, t0 + j, c * 128 + j, CN_B + g * 128 + 8 * cc, 1024 + g * 128 + 8 * cc, o);
#pragma unroll
        for (int e = 0; e < 8; ++e) BT[(8 * cc + e) * 136 + j] = f2bf(o[e]);
    }
    if (tid < 8) sdec[bc * 16 + g * 8 + tid] = __expf(acL[tid * 128 + 127]);
    __syncthreads();
    const int fr = lane & 15, fq = lane >> 4;
#pragma unroll 1
    for (int hh = 0; hh < 8; ++hh) {
        const int hd = g * 8 + hh;
        const float alast = acL[hh * 128 + 127];
        for (int idx = tid; idx < 1024; idx += NTHR) {
            const int jc = idx & 15, p = idx >> 4;
            float o[8];
            conv8_tr(PT, cw, cb, 1024 + hd * 64 + p, t0 + 8 * jc, (c * 128 + 8 * jc) > 0, hd * 64 + p, o);
#pragma unroll
            for (int e = 0; e < 8; ++e) { const int j = 8 * jc + e; o[e] *= dtL[hh * 128 + j] * __expf(alast - acL[hh * 128 + j]); }
            u32x4 pk; pk.x = pk2(o[0], o[1]); pk.y = pk2(o[2], o[3]); pk.z = pk2(o[4], o[5]); pk.w = pk2(o[6], o[7]);
            *(LAS u32x4*)(XT + p * 136 + 8 * jc) = pk;
        }
        __syncthreads();
        const int mt = wave & 3, nh = wave >> 2;
        f32x4 acc[4];
#pragma unroll
        for (int n4 = 0; n4 < 4; ++n4) acc[n4] = (f32x4){0.f, 0.f, 0.f, 0.f};
#pragma unroll
        for (int ks = 0; ks < 4; ++ks) {
            const bf16x8 af = lfrag(XT, mt * 16 + fr, 136, ks * 32 + 8 * fq);
#pragma unroll
            for (int n4 = 0; n4 < 4; ++n4) acc[n4] = mma16(af, lfrag(BT, (nh * 4 + n4) * 16 + fr, 136, ks * 32 + 8 * fq), acc[n4]);
        }
        bf16_t* So = SS + (size_t)(bc * 16 + hd) * 8192;
#pragma unroll
        for (int n4 = 0; n4 < 4; ++n4) {
            u32x2 o; o.x = pk2(acc[n4][0], acc[n4][1]); o.y = pk2(acc[n4][2], acc[n4][3]);
            *(u32x2*)(So + (mt * 16 + fr) * 128 + (nh * 4 + n4) * 16 + 4 * fq) = o;
        }
        __syncthreads();
    }
}

__device__ __forceinline__ void ssd_out_item(LAS unsigned char* lds, bf16_t* __restrict__ PN, const bf16_t* __restrict__ PT, const float* __restrict__ cw, const float* __restrict__ cb,
                                             const float* __restrict__ dt_bias, const float* __restrict__ a_log, const float* __restrict__ d_skip, const float* __restrict__ snw,
                                             const bf16_t* __restrict__ SS, int item, int tid, int wave, int lane) {
    const int g = item & 1, bc = item >> 1, c = bc & 63, t0 = bc * 128;
    ssd_dt_prep(lds, PN, dt_bias, a_log, t0, g, tid, wave, lane);
    const LAS float* dtL = (const LAS float*)(lds + SS_OFF_DT); const LAS float* acL = (const LAS float*)(lds + SS_OFF_AC);
    LAS bf16_t* Cn = (LAS bf16_t*)(lds + S5_OFF_CN); LAS bf16_t* Bn = (LAS bf16_t*)(lds + S5_OFF_BN);
    LAS bf16_t* Wh = (LAS bf16_t*)(lds + S5_OFF_WH); LAS bf16_t* XT = (LAS bf16_t*)(lds + S5_OFF_XT);
    for (int idx = tid; idx < 4096; idx += NTHR) {
        const int cc = idx & 15, j = (idx >> 4) & 127, which = idx >> 11;
        float o[8];
        conv8_nat(PN, cw, cb, t0 + j, c * 128 + j, (which ? CN_C : CN_B) + g * 128 + 8 * cc, 1024 + which * 256 + g * 128 + 8 * cc, o);
        u32x4 pk; pk.x = pk2(o[0], o[1]); pk.y = pk2(o[2], o[3]); pk.z = pk2(o[4], o[5]); pk.w = pk2(o[6], o[7]);
        *(LAS u32x4*)((which ? Cn : Bn) + j * 136 + 8 * cc) = pk;
    }
    __syncthreads();
    const int fr = lane & 15, fq = lane >> 4;
    bf16x8 cf[4];
#pragma unroll
    for (int ks = 0; ks < 4; ++ks) cf[ks] = lfrag(Cn, wave * 16 + fr, 136, ks * 32 + 8 * fq);
    f32x4 cbv[8];
#pragma unroll
    for (int nt = 0; nt < 8; ++nt) {
        cbv[nt] = (f32x4){0.f, 0.f, 0.f, 0.f};
        if (nt <= wave) {
#pragma unroll
            for (int ks = 0; ks < 4; ++ks) cbv[nt] = mma16(cf[ks], lfrag(Bn, nt * 16 + fr, 136, ks * 32 + 8 * fq), cbv[nt]);
        }
    }
    const int i = wave * 16 + fr;
    float ss = 0.f;
#pragma unroll 1
    for (int hh = 0; hh < 8; ++hh) {
        const int hd = g * 8 + hh;
        for (int idx = tid; idx < 1024; idx += NTHR) {
            const int jc = idx & 15, p = idx >> 4;
            float o[8];
            conv8_tr(PT, cw, cb, 1024 + hd * 64 + p, t0 + 8 * jc, (c * 128 + 8 * jc) > 0, hd * 64 + p, o);
            u32x4 pk; pk.x = pk2(o[0], o[1]); pk.y = pk2(o[2], o[3]); pk.z = pk2(o[4], o[5]); pk.w = pk2(o[6], o[7]);
            *(LAS u32x4*)(XT + p * 136 + 8 * jc) = pk;
        }
        const float aci = acL[hh * 128 + i];
#pragma unroll
        for (int nt = 0; nt < 8; ++nt) {
            if (nt <= (wave | 1)) {
                const int j0 = nt * 16 + 4 * fq;
                const f32x4 acj = *(const LAS f32x4*)(acL + hh * 128 + j0), dtj = *(const LAS f32x4*)(dtL + hh * 128 + j0);
                float v[4];
#pragma unroll
                for (int r = 0; r < 4; ++r) { const float t = cbv[nt][r] * __expf(aci - acj[r]) * dtj[r]; v[r] = (j0 + r <= i) ? t : 0.f; }
                u32x2 o; o.x = pk2(v[0], v[1]); o.y = pk2(v[2], v[3]);
                *(LAS u32x2*)(Wh + i * 136 + j0) = o;
            }
        }
        __syncthreads();
        f32x4 y1[4], y2[4];
#pragma unroll
        for (int nt = 0; nt < 4; ++nt) { y1[nt] = (f32x4){0.f, 0.f, 0.f, 0.f}; y2[nt] = (f32x4){0.f, 0.f, 0.f, 0.f}; }
#ifndef SSD_NO_Y1
#pragma unroll
        for (int ks = 0; ks < 4; ++ks) {
            if (ks <= (wave >> 1)) {
                const bf16x8 af = lfrag(Wh, wave * 16 + fr, 136, ks * 32 + 8 * fq);
#pragma unroll
                for (int nt = 0; nt < 4; ++nt) y1[nt] = mma16(af, lfrag(XT, nt * 16 + fr, 136, ks * 32 + 8 * fq), y1[nt]);
            }
        }
#endif
        const bf16_t* Sp = SS + (size_t)(bc * 16 + hd) * 8192;
#ifndef SSD_NO_Y2
#pragma unroll
        for (int ks = 0; ks < 4; ++ks)
#pragma unroll
            for (int nt = 0; nt < 4; ++nt) y2[nt] = mma16(cf[ks], gfrag(Sp + (nt * 16 + fr) * 128 + ks * 32 + 8 * fq), y2[nt]);
#endif
        const float eai = __expf(aci), Dh = d_skip[hd];
#pragma unroll
        for (int nt = 0; nt < 4; ++nt) {
            const int p0 = nt * 16 + 4 * fq;
            bf16_t* zp = PN + (size_t)(t0 + i) * NPN + CN_Z + hd * 64 + p0;
            const u32x2 zr = *(const u32x2*)zp;
            float yz[4];
#pragma unroll
            for (int r = 0; r < 4; ++r) {
                const float xv = bf2f(XT[(p0 + r) * 136 + i]);
                const float y = y1[nt][r] + eai * y2[nt][r] + Dh * xv;
                const float z = (r == 0) ? bflo(zr.x) : (r == 1) ? bfhi(zr.x) : (r == 2) ? bflo(zr.y) : bfhi(zr.y);
                yz[r] = y * silu_f(z);
                ss += yz[r] * yz[r];
            }
            u32x2 yo; yo.x = pk2(yz[0], yz[1]); yo.y = pk2(yz[2], yz[3]);
            *(u32x2*)zp = yo;
        }
        __syncthreads();
    }
    ss += __shfl_xor(ss, 16); ss += __shfl_xor(ss, 32);
    const float rstd = rsqrtf(ss * (1.f / 512.f) + EPS);
#pragma unroll 2
    for (int hh = 0; hh < 8; ++hh)
#pragma unroll
        for (int nt = 0; nt < 4; ++nt) {
            const int p0 = nt * 16 + 4 * fq, hd = g * 8 + hh;
            const f32x4 nw = *(const f32x4*)(snw + g * 512 + hh * 64 + p0);
            bf16_t* zp = PN + (size_t)(t0 + i) * NPN + CN_Z + hd * 64 + p0;
            const u32x2 yv = *(const u32x2*)zp;
            u32x2 o;
            o.x = pk2(bflo(yv.x) * rstd * nw[0], bfhi(yv.x) * rstd * nw[1]);
            o.y = pk2(bflo(yv.y) * rstd * nw[2], bfhi(yv.y) * rstd * nw[3]);
            *(u32x2*)zp = o;
        }
    __syncthreads();
}

__device__ __forceinline__ void scan_gla(unsigned char* ws, const float* __restrict__ gdec, int tid) {
    const int gt = blockIdx.x * NTHR + tid, GT = gridDim.x * NTHR;
    for (int w = gt; w < 8 * 16384; w += GT) {
        const int bh = w >> 14, e2 = w & 16383, b = bh >> 2, h = bh & 3, kk = (2 * e2) & 127;
        bf16_t* p = sg_item(ws, b * 512 + h) + 2 * e2;
        const float* dp = gdec + (size_t)(b * 512 + h) * 128 + kk;
        float s0 = 0.f, s1 = 0.f;
        for (int n0 = 0; n0 < 128; n0 += 8) {
            unsigned u[8]; f32x2 d[8];
#pragma unroll
            for (int q = 0; q < 8; ++q) { u[q] = *(const unsigned*)(p + (size_t)(n0 + q) * 131072); d[q] = *(const f32x2*)(dp + (n0 + q) * 512); }
#pragma unroll
            for (int q = 0; q < 8; ++q) { *(unsigned*)(p + (size_t)(n0 + q) * 131072) = pk2(s0, s1); s0 = s0 * d[q].x + bflo(u[q]); s1 = s1 * d[q].y + bfhi(u[q]); }
        }
    }
}
__device__ __forceinline__ void scan_ssd(bf16_t* SS, const float* __restrict__ sdec, int tid) {
    const int gt = blockIdx.x * NTHR + tid, GT = gridDim.x * NTHR;
    for (int w = gt; w < 32 * 4096; w += GT) {
        const int bh = w >> 12, e2 = w & 4095, b = bh >> 4, h = bh & 15;
        bf16_t* p = SS + (size_t)(b * 1024 + h) * 8192 + 2 * e2;
        const float* dp = sdec + b * 1024 + h;
        float s0 = 0.f, s1 = 0.f;
        for (int c0 = 0; c0 < 64; c0 += 8) {
            unsigned u[8]; float d[8];
#pragma unroll
            for (int q = 0; q < 8; ++q) { u[q] = *(const unsigned*)(p + (size_t)(c0 + q) * 131072); d[q] = dp[(c0 + q) * 16]; }
#pragma unroll
            for (int q = 0; q < 8; ++q) { *(unsigned*)(p + (size_t)(c0 + q) * 131072) = pk2(s0, s1); s0 = s0 * d[q] + bflo(u[q]); s1 = s1 * d[q] + bfhi(u[q]); }
        }
    }
}

__device__ __forceinline__ void phase7(const float* __restrict__ x, const bf16_t* __restrict__ MX, const float* __restrict__ post_w, const unsigned char* ws_c, float* __restrict__ out, int wave, int lane) {
    const float* ada = (const float*)(ws_c + WS_ADA);
    const int gw = blockIdx.x * NWAVES + wave, NGW = gridDim.x * NWAVES;
    for (int m = gw; m < M; m += NGW) {
        const int b = m >> 13;
        float v[16]; float s = 0.f;
#pragma unroll
        for (int jj = 0; jj < 2; ++jj) {
            const u32x4 r = *(const u32x4*)(MX + (size_t)m * D + 512 * jj + 8 * lane);
            v[8 * jj + 0] = bflo(r.x); v[8 * jj + 1] = bfhi(r.x); v[8 * jj + 2] = bflo(r.y); v[8 * jj + 3] = bfhi(r.y);
            v[8 * jj + 4] = bflo(r.z); v[8 * jj + 5] = bfhi(r.z); v[8 * jj + 6] = bflo(r.w); v[8 * jj + 7] = bfhi(r.w);
        }
#pragma unroll
        for (int e = 0; e < 16; ++e) s += v[e] * v[e];
        const float rstd = rsqrtf(wave_sum(s) * (1.f / D) + EPS);
#pragma unroll
        for (int jj = 0; jj < 2; ++jj)
#pragma unroll
            for (int q = 0; q < 2; ++q) {
                const int col = 512 * jj + 8 * lane + 4 * q;
                const f32x4 xv = *(const f32x4*)(x + (size_t)m * D + col), gt = *(const f32x4*)(ada + b * 3072 + 2048 + col), pw = *(const f32x4*)(post_w + col);
                f32x4 o;
                o[0] = xv[0] + gt[0] * (v[8 * jj + 4 * q + 0] * rstd * pw[0]); o[1] = xv[1] + gt[1] * (v[8 * jj + 4 * q + 1] * rstd * pw[1]);
                o[2] = xv[2] + gt[2] * (v[8 * jj + 4 * q + 2] * rstd * pw[2]); o[3] = xv[3] + gt[3] * (v[8 * jj + 4 * q + 3] * rstd * pw[3]);
                *(f32x4*)(out + (size_t)m * D + col) = o;
            }
    }
}

struct Args { const float* in[17]; float* out; unsigned char* ws; int ph_lo, ph_hi; };
#define GAS __attribute__((address_space(1)))
__device__ __forceinline__ const float* karg(int i) {
    const unsigned long long* ka = (const unsigned long long*)__builtin_amdgcn_kernarg_segment_ptr(); asm volatile("" : "+s"(ka));
    return (const float*)(const GAS float*)ka[i];
}
__global__ void __launch_bounds__(NTHR, 2) fwd_megakernel(Args args) {
    extern __shared__ __attribute__((aligned(16))) unsigned char lds_raw[];
    LAS unsigned char* lds = (LAS unsigned char*)lds_raw;
    cg::grid_group grid = cg::this_grid();
    const int tid = threadIdx.x, lane = tid & 63, wave = __builtin_amdgcn_readfirstlane(tid >> 6);
    const int G = gridDim.x;
    unsigned char* ws = args.ws;
    bf16_t* WT = (bf16_t*)(ws + WS_WT); bf16_t* WOT = (bf16_t*)(ws + WS_WOUT); bf16_t* H = (bf16_t*)(ws + WS_H);
    bf16_t* PN = (bf16_t*)(ws + WS_PN); bf16_t* PT = (bf16_t*)(ws + WS_PT);
    bf16_t* SS = (bf16_t*)(ws + WS_SS);
    bf16_t* MX = (bf16_t*)(ws + WS_PT);
    float* gdec = (float*)(ws + WS_GDEC); float* sdec = (float*)(ws + WS_SDEC);
    const int lo = args.ph_lo, hi = args.ph_hi;
#define IN(k) (lo <= (k) && (k) < hi)
#define SEAM(k) do { if (IN(k) && IN((k) + 1)) grid.sync(); } while (0)

    if (IN(0)) { phase0(lds, karg(1), karg(2), karg(3), karg(5), karg(15), ws, tid, wave, lane); }
    SEAM(0);
    if (IN(1)) { phase1(karg(0), karg(4), ws, H, wave, lane); }
    SEAM(1);
    if (IN(2)) {
        { pg8::Gemm g{H, WT, M, NPN, D, D, D}; pg8::StaticOrder S; S.init(M, NPN, G, (int)blockIdx.x);
          pg8::EpiBf16<0> E{PN, NPN, nullptr, 0, 0, 1.f};
          pg8::gemm_phase<pg8::EpiBf16<0>, pg8::StaticOrder, true, true>(lds, g, S, E); }
        { pg8::Gemm g{WT + (size_t)NPN * D, H, NPT, M, D, D, D}; pg8::StaticOrder S; S.init(NPT, M, G, (int)blockIdx.x);
          pg8::EpiBf16<0> E{PT, M, nullptr, 0, 0, 1.f};
          pg8::gemm_phase<pg8::EpiBf16<0>, pg8::StaticOrder, true, true>(lds, g, S, E); }
    }
    SEAM(2);
    if (IN(3)) {
        for (int it = blockIdx.x; it < 1024; it += G) gla_state_item(lds, PN, PT, karg(6), karg(7), gdec, (unsigned char*)args.out, it, tid, wave, lane);
        for (int it = blockIdx.x; it < 256; it += G) ssd_state_item(lds, PN, PT, karg(9), karg(10), karg(11), karg(12), sdec, SS, it, tid, wave, lane);
    }
    SEAM(3);
    if (IN(4)) { scan_gla((unsigned char*)args.out, gdec, tid); scan_ssd(SS, sdec, tid); }
    SEAM(4);
    if (IN(5)) {
        for (int it = blockIdx.x; it < 1024; it += G) gla_out_item(lds, PN, PT, karg(6), karg(7), karg(8), (unsigned char*)args.out, it, tid, wave, lane);
        for (int it = blockIdx.x; it < 256; it += G) ssd_out_item(lds, PN, PT, karg(9), karg(10), karg(11), karg(12), karg(13), karg(14), SS, it, tid, wave, lane);
    }
    SEAM(5);
    if (IN(6)) {
        pg8::Gemm g{PN, WOT, M, D, DMIX, NPN, DMIX}; pg8::StaticOrder S; S.init(M, D, G, (int)blockIdx.x);
        pg8::EpiBf16<0> E{MX, D, nullptr, 0, 0, 1.f};
        pg8::gemm_phase<pg8::EpiBf16<0>, pg8::StaticOrder, true, true>(lds, g, S, E);
    }
    SEAM(6);
    if (IN(7)) { phase7(karg(0), MX, karg(16), ws, (float*)karg(17), wave, lane); }
#undef IN
#undef SEAM
}

extern "C" void kernel_launch(void* const* d_in, const int* in_sizes, int n_in, void* d_out, int out_size, void* d_ws, size_t ws_size, hipStream_t stream) {
    static int grid = 0;
    if (grid == 0) {
        if (n_in != 17 || out_size != M * D || ws_size < WS_END) { fprintf(stderr, "kernel_launch: unexpected shapes (n_in %d, out %d, ws %zu)\n", n_in, out_size, ws_size); grid = -1; return; }
        int dev = 0, cus = 0, per_cu = 0;
        hipGetDevice(&dev);
        hipDeviceGetAttribute(&cus, hipDeviceAttributeMultiprocessorCount, dev);
        if (hipFuncSetAttribute((const void*)fwd_megakernel, hipFuncAttributeMaxDynamicSharedMemorySize, LDS_BYTES) != hipSuccess) { fprintf(stderr, "kernel_launch: hipFuncSetAttribute failed\n"); grid = -1; return; }
        if (hipOccupancyMaxActiveBlocksPerMultiprocessor(&per_cu, (const void*)fwd_megakernel, NTHR, LDS_BYTES) != hipSuccess || per_cu < 1) { fprintf(stderr, "kernel_launch: occupancy query gave %d\n", per_cu); per_cu = 1; }
        (void)hipGetLastError();
        grid = cus * per_cu;
        fprintf(stderr, "kernel_launch: grid %d (%d CUs x %d)\n", grid, cus, per_cu);
    }
    if (grid < 0) return;
    Args a{};
    for (int i = 0; i < 17; ++i) a.in[i] = (const float*)d_in[i];
    a.out = (float*)d_out; a.ws = (unsigned char*)d_ws;
#if MK_N_LAUNCHES == 1
    a.ph_lo = 0; a.ph_hi = NPHASE;
    void* kargs[] = {&a};
    hipError_t e = hipLaunchCooperativeKernel((const void*)fwd_megakernel, dim3(grid), dim3(NTHR), kargs, LDS_BYTES, stream);
    if (e != hipSuccess) fprintf(stderr, "kernel_launch: cooperative launch failed: %s (grid %d)\n", hipGetErrorString(e), grid);
#else
    for (int p = 0; p < NPHASE; ++p) {
        a.ph_lo = p; a.ph_hi = p + 1;
        hipLaunchKernelGGL(fwd_megakernel, dim3(grid), dim3(NTHR), LDS_BYTES, stream, a);
    }
#endif
}
```

```cpp
#include <hip/hip_runtime.h>
#include <hip/hip_cooperative_groups.h>
#include <cstdio>
#include <cstdint>
namespace cg = cooperative_groups;
namespace pg8 {
#define PG8_LAS __attribute__((address_space(3)))
typedef unsigned short bf16_t;
typedef short bf16x8 __attribute__((ext_vector_type(8)));
typedef float f32x4 __attribute__((ext_vector_type(4)));
typedef unsigned u32x4 __attribute__((ext_vector_type(4)));
constexpr int BM = 256, BK = 64, HALF = 128, HTB = HALF * BK * 2  , STAGE_BYTES = 8 * HTB, NXCD = 8, WGM = 8;

__host__ __device__ __forceinline__ int lds_byte(int r, int c) { const int st = (r >> 4) * 2 + (c >> 5), rr = r & 15, cc = c & 31, ob = rr * 64 + cc * 2; return st * 1024 + (ob ^ (((ob >> 9) & 1) << 5)); }
__host__ __device__ __forceinline__ void stage_rc(int b, int& R, int& C) { const int st = b / 1024, sb = b % 1024, swz = sb ^ (((sb >> 9) & 1) << 5); R = (st >> 1) * 16 + swz / 64; C = (st & 1) * 32 + (swz % 64) / 2; }
__host__ __device__ __forceinline__ int perm32(int rho) { const int n = rho >> 4, i = rho & 15; return 8 * (i >> 2) + 4 * n + (i & 3); }

struct Unit { int pm, pn; };
struct Gemm { const bf16_t* A; const bf16_t* Bt; int M, N, K, lda, ldb; };

struct StaticOrder {
    int nM, nN, nwg, G, c;
    __host__ __device__ void init(int M, int N, int G_, int c_) { nM = M / BM; nN = N / BM; nwg = nM * nN; G = G_; c = c_; }
    __host__ __device__ bool next(int i, Unit& u) const {
        const long L = (long)i * G + c; if (L >= nwg) return false;
        int wgid = (int)L; { const int q = nwg / NXCD, r = nwg % NXCD, xcd = wgid % NXCD, off = wgid / NXCD; wgid = (xcd < r ? xcd * (q + 1) : r * (q + 1) + (xcd - r) * q) + off; }
        const int nig = WGM * nN, gid = wgid / nig, fm = gid * WGM, gsz = (nM - fm) < WGM ? (nM - fm) : WGM;
        u.pm = fm + ((wgid % nig) % gsz); u.pn = (wgid % nig) / gsz; return true;
    }
    __device__ __forceinline__ void a_ready(const Unit&) const {}
    __device__ __forceinline__ void done(const Unit&) const {}
};

__device__ __forceinline__ unsigned cvt_pk_bf16(float lo, float hi) { unsigned r; asm volatile("v_cvt_pk_bf16_f32 %0, %1, %2" : "=v"(r) : "v"(lo), "v"(hi)); return r; }
typedef float f32x2 __attribute__((ext_vector_type(2)));
__device__ __forceinline__ f32x2 gelu_pk(f32x2 v) {
    const f32x2 av = __builtin_elementwise_abs(v), d = av * 0.2316418882f + 1.0f;
    f32x2 t; t.x = __builtin_amdgcn_rcpf(d.x); t.y = __builtin_amdgcn_rcpf(d.y);
    f32x2 q = t * 0.5307027145f + (-0.7265760135f); q = q * t + 0.7107068705f; q = q * t + (-0.142248368f); q = q * t + 0.127414796f; q = q * t;
    const f32x2 s = (v * v) * (-0.72134752044f);
    f32x2 e; e.x = __builtin_amdgcn_exp2f(s.x); e.y = __builtin_amdgcn_exp2f(s.y);
    const f32x2 m = v * (q * e), r = v - m;
    f32x2 o; o.x = v.x < 0.f ? m.x : r.x; o.y = v.y < 0.f ? m.y : r.y; return o;
}

template <int ACT  > struct EpiBf16 {
    static constexpr bool PERM = true, AFTER_DRAIN = false; static_assert(ACT == 0 || ACT == 1, "EpiBf16: ACT is 0 (none) or 1 (gelu_pk)");
    bf16_t* O; int ldc; const float* bias; int split_cols; size_t split_stride; float scale0;
    __device__ __forceinline__ void operator()(const f32x4 (&acc)[2][2][4][2], const Unit& u, int wr, int wc, int fr, int fq) const {
        const int row0 = u.pm * BM + wr * 64 + fr; int colt = u.pn * BM; bf16_t* base = O;
        float sc = 1.f; if (split_cols) { const int t = colt / split_cols; base += (size_t)t * split_stride; colt -= t * split_cols; if (t == 0) sc = scale0; }
        const int col0 = colt + wc * 32 + 8 * fq, bcol0 = u.pn * BM + wc * 32 + 8 * fq;
        f32x4 bv[2][2];
#pragma unroll
        for (int bj = 0; bj < 2; ++bj)
#pragma unroll
            for (int n = 0; n < 2; ++n) bv[bj][n] = bias ? *(const f32x4*)(bias + bcol0 + bj * HALF + 4 * n) : (f32x4){0.f, 0.f, 0.f, 0.f};
#pragma unroll
        for (int ai = 0; ai < 2; ++ai)
#pragma unroll
            for (int m = 0; m < 4; ++m) { bf16_t* rowp = base + (size_t)(row0 + ai * HALF + m * 16) * ldc + col0;
#pragma unroll
                for (int bj = 0; bj < 2; ++bj) { f32x4 v0 = acc[ai][bj][m][0] + bv[bj][0], v1 = acc[ai][bj][m][1] + bv[bj][1];
                    if (ACT == 1) { f32x2 a = gelu_pk((f32x2){v0[0], v0[1]}), b = gelu_pk((f32x2){v0[2], v0[3]}), c = gelu_pk((f32x2){v1[0], v1[1]}), d = gelu_pk((f32x2){v1[2], v1[3]});
                        v0 = (f32x4){a.x, a.y, b.x, b.y}; v1 = (f32x4){c.x, c.y, d.x, d.y}; }
                    v0 = v0 * sc; v1 = v1 * sc; u32x4 w; w.x = cvt_pk_bf16(v0[0], v0[1]); w.y = cvt_pk_bf16(v0[2], v0[3]); w.z = cvt_pk_bf16(v1[0], v1[1]); w.w = cvt_pk_bf16(v1[2], v1[3]);
                    *(u32x4*)(rowp + bj * HALF) = w; } }
    }
};
template <class Epi, class Sched, bool ALIGN_EPI = false, bool SP2 = false>
__device__ __forceinline__ void gemm_phase(PG8_LAS unsigned char* lds, const Gemm g, const Sched& S, const Epi& E) {
    const int tid = threadIdx.x, wid = __builtin_amdgcn_readfirstlane(tid >> 6), lane = tid & 63, wr = wid >> 2, wc = wid & 3, fr = lane & 15, fq = lane >> 4;
    const int K = g.K, nt = K / BK;
    unsigned voffA[2], voffB[2];
#pragma unroll
    for (int i = 0; i < 2; ++i) { int R, C; stage_rc(tid * 16 + i * 8192, R, C); const int Rb = Epi::PERM ? ((R & ~31) + perm32(R & 31)) : R;
        voffA[i] = (unsigned)(R * g.lda + C) * 2u; voffB[i] = (unsigned)(Rb * g.ldb + C) * 2u; }
    const size_t kstep = (size_t)(BK * 2);
    const size_t hstepA = (size_t)HALF * g.lda * 2, hstepB = (size_t)HALF * g.ldb * 2;
    const size_t tstepA = 2 * hstepA, tstepB = 2 * hstepB;
    const unsigned ldsw = (unsigned)wid * 1024u;
    const int aoff = lds_byte(wr * 64 + fr, fq * 8), boff = lds_byte(wc * 32 + fr, fq * 8);
#define PG8_SA(b, h) (((b) * 2 + (h)) * HTB)
#define PG8_SB(b, h) ((4 + (b) * 2 + (h)) * HTB)
#define PG8_STAGE(bufoff, gbase, voff) do { _Pragma("unroll") for (int _i = 0; _i < 2; ++_i) \
        __builtin_amdgcn_global_load_lds((const unsigned*)((const char*)(gbase) + (voff)[_i]), (PG8_LAS unsigned*)(lds + (bufoff) + ldsw + _i * 8192), 16, 0, 0); } while (0)
#define PG8_LDA(dst, b, h) do { _Pragma("unroll") for (int m = 0; m < 4; ++m) _Pragma("unroll") for (int k = 0; k < 2; ++k) dst[m][k] = *(const PG8_LAS bf16x8*)(lds + PG8_SA(b, h) + aoff + m * 2048 + k * 1024); } while (0)
#define PG8_LDB(dst, b, h) do { _Pragma("unroll") for (int n = 0; n < 2; ++n) _Pragma("unroll") for (int k = 0; k < 2; ++k) dst[n][k] = *(const PG8_LAS bf16x8*)(lds + PG8_SB(b, h) + boff + n * 2048 + k * 1024); } while (0)
#define PG8_MMA(ai, bj, At, Bt) do { __builtin_amdgcn_s_setprio(1); _Pragma("unroll") for (int m = 0; m < 4; ++m) _Pragma("unroll") for (int n = 0; n < 2; ++n) _Pragma("unroll") for (int k = 0; k < 2; ++k) \
        acc[ai][bj][m][n] = __builtin_amdgcn_mfma_f32_16x16x32_bf16(Bt[n][k], At[m][k], acc[ai][bj][m][n], 0, 0, 0); __builtin_amdgcn_s_setprio(0); } while (0)
#define PG8_WAIT_V(n) asm volatile("s_waitcnt vmcnt(" #n ")" ::: "memory")
#define PG8_WAIT_L(n) asm volatile("s_waitcnt lgkmcnt(" #n ")" ::: "memory")
#define PG8_BAR __builtin_amdgcn_s_barrier()
#define PG8_SCHED __builtin_amdgcn_sched_barrier(0)
    Unit cur, nxt; int ui = 0;
    if (!S.next(0, cur)) return;
    f32x4 acc[2][2][4][2];
#pragma unroll
    for (int a = 0; a < 2; ++a)
#pragma unroll
        for (int b = 0; b < 2; ++b)
#pragma unroll
            for (int m = 0; m < 4; ++m)
#pragma unroll
                for (int n = 0; n < 2; ++n) acc[a][b][m][n] = (f32x4){0.f, 0.f, 0.f, 0.f};
    bf16x8 At[4][2], B0[2][2], B1[2][2];
    const char* cA = (const char*)g.A + (size_t)cur.pm * tstepA; const char* cB = (const char*)g.Bt + (size_t)cur.pn * tstepB;
    S.a_ready(cur);
    if constexpr (SP2) {
        PG8_STAGE(PG8_SB(0, 0), cB, voffB); PG8_STAGE(PG8_SB(0, 1), cB + hstepB, voffB); PG8_STAGE(PG8_SA(0, 0), cA, voffA); PG8_STAGE(PG8_SA(0, 1), cA + hstepA, voffA);
        if (wr == 1) PG8_BAR;
        PG8_WAIT_V(2); PG8_BAR;
        PG8_STAGE(PG8_SB(1, 0), cB + kstep, voffB); PG8_STAGE(PG8_SA(1, 0), cA + kstep, voffA); PG8_STAGE(PG8_SB(1, 1), cB + hstepB + kstep, voffB);
        PG8_WAIT_V(6); PG8_BAR;
    } else {
        PG8_STAGE(PG8_SB(0, 0), cB, voffB); PG8_STAGE(PG8_SA(0, 0), cA, voffA); PG8_STAGE(PG8_SB(0, 1), cB + hstepB, voffB); PG8_STAGE(PG8_SA(0, 1), cA + hstepA, voffA);
        if (wr == 1) PG8_BAR;
        PG8_WAIT_V(4); PG8_BAR;
        PG8_STAGE(PG8_SB(1, 0), cB + kstep, voffB); PG8_STAGE(PG8_SA(1, 0), cA + kstep, voffA); PG8_STAGE(PG8_SB(1, 1), cB + hstepB + kstep, voffB);
        PG8_WAIT_V(6); PG8_BAR;
    }
    for (;;) {
        const bool has_next = S.next(ui + 1, nxt);
        const char* nA = has_next ? (const char*)g.A + (size_t)nxt.pm * tstepA : cA; const char* nB = has_next ? (const char*)g.Bt + (size_t)nxt.pn * tstepB : cB;
        for (int t = 0; t < nt; t += 2) {
            const bool last = (t == nt - 2);
            const char* a1 = cA + (size_t)(t + 1) * kstep;
            const char* a2 = last ? nA : cA + (size_t)(t + 2) * kstep; const char* b2 = last ? nB : cB + (size_t)(t + 2) * kstep;
            const char* a3 = a2 + kstep; const char* b3 = b2 + kstep;
            if (last && has_next) S.a_ready(nxt);
            if constexpr (SP2) {
            PG8_LDB(B0, 0, 0); PG8_LDB(B1, 0, 1); PG8_SCHED; PG8_LDA(At, 0, 0); PG8_STAGE(PG8_SA(1, 1), a1 + hstepA, voffA);
            PG8_WAIT_V(8); PG8_WAIT_L(0); PG8_BAR; PG8_MMA(0, 0, At, B0); PG8_MMA(0, 1, At, B1); PG8_BAR; PG8_SCHED;
            PG8_LDA(At, 0, 1); PG8_STAGE(PG8_SB(0, 0), b2, voffB); PG8_STAGE(PG8_SB(0, 1), b2 + hstepB, voffB); PG8_STAGE(PG8_SA(0, 0), a2, voffA);
            PG8_WAIT_V(8); PG8_WAIT_L(0); PG8_BAR; PG8_MMA(1, 0, At, B0); PG8_MMA(1, 1, At, B1); PG8_BAR; PG8_SCHED;
            PG8_LDB(B0, 1, 0); PG8_LDB(B1, 1, 1); PG8_SCHED; PG8_LDA(At, 1, 0); PG8_STAGE(PG8_SA(0, 1), a2 + hstepA, voffA);
            PG8_WAIT_V(8); PG8_WAIT_L(0); PG8_BAR; PG8_MMA(0, 0, At, B0); PG8_MMA(0, 1, At, B1); PG8_BAR; PG8_SCHED;
            PG8_LDA(At, 1, 1); PG8_STAGE(PG8_SB(1, 0), b3, voffB); PG8_STAGE(PG8_SB(1, 1), b3 + hstepB, voffB); PG8_STAGE(PG8_SA(1, 0), a3, voffA);
            PG8_WAIT_V(8); PG8_WAIT_L(0); PG8_BAR; PG8_MMA(1, 0, At, B0); PG8_MMA(1, 1, At, B1); PG8_BAR; PG8_SCHED;
            } else {
            PG8_LDB(B0, 0, 0); PG8_SCHED; PG8_LDA(At, 0, 0); PG8_STAGE(PG8_SA(1, 1), a1 + hstepA, voffA);
            PG8_WAIT_L(8); PG8_BAR; PG8_WAIT_L(0); PG8_MMA(0, 0, At, B0); PG8_BAR; PG8_SCHED;
            PG8_LDB(B1, 0, 1); PG8_STAGE(PG8_SB(0, 0), b2, voffB);
            PG8_BAR; PG8_WAIT_L(0); PG8_MMA(0, 1, At, B1); PG8_BAR;
            PG8_LDA(At, 0, 1); PG8_STAGE(PG8_SA(0, 0), a2, voffA);
            PG8_BAR; PG8_WAIT_L(0); PG8_MMA(1, 0, At, B0); PG8_BAR; PG8_SCHED;
            PG8_STAGE(PG8_SB(0, 1), b2 + hstepB, voffB);
            PG8_WAIT_V(6); PG8_BAR; PG8_MMA(1, 1, At, B1); PG8_BAR;
            PG8_LDB(B0, 1, 0); PG8_SCHED; PG8_LDA(At, 1, 0); PG8_STAGE(PG8_SA(0, 1), a2 + hstepA, voffA);
            PG8_WAIT_L(8); PG8_BAR; PG8_WAIT_L(0); PG8_MMA(0, 0, At, B0); PG8_BAR; PG8_SCHED;
            PG8_LDB(B1, 1, 1); PG8_STAGE(PG8_SB(1, 0), b3, voffB);
            PG8_BAR; PG8_WAIT_L(0); PG8_MMA(0, 1, At, B1); PG8_BAR;
            PG8_LDA(At, 1, 1); PG8_STAGE(PG8_SA(1, 0), a3, voffA);
            PG8_BAR; PG8_WAIT_L(0); PG8_MMA(1, 0, At, B0); PG8_BAR; PG8_SCHED;
            PG8_STAGE(PG8_SB(1, 1), b3 + hstepB, voffB);
            PG8_WAIT_V(6); PG8_BAR; PG8_MMA(1, 1, At, B1); PG8_BAR;
            }
        }
        if constexpr (ALIGN_EPI) { if (wr == 0) PG8_BAR; }
        if constexpr (!Epi::AFTER_DRAIN) { E(acc, cur, wr, wc, fr, fq); S.done(cur); }
        if (!has_next) break;
#pragma unroll
        for (int a = 0; a < 2; ++a)
#pragma unroll
            for (int b = 0; b < 2; ++b)
#pragma unroll
                for (int m = 0; m < 4; ++m)
#pragma unroll
                    for (int n = 0; n < 2; ++n) acc[a][b][m][n] = (f32x4){0.f, 0.f, 0.f, 0.f};
        cur = nxt; cA = nA; cB = nB; ++ui;
        if constexpr (ALIGN_EPI) { if (wr == 1) PG8_BAR; }
    }
    PG8_WAIT_V(0);
    if constexpr (!ALIGN_EPI) { if (wr == 0) PG8_BAR; }
    PG8_BAR;
    if constexpr (Epi::AFTER_DRAIN) { E.fused(acc, cur, wr, wc, fr, fq, lds, wid, lane); S.done(cur); }
#undef PG8_SA
#undef PG8_SB
#undef PG8_STAGE
#undef PG8_LDA
#undef PG8_LDB
#undef PG8_MMA
#undef PG8_WAIT_V
#undef PG8_WAIT_L
#undef PG8_BAR
#undef PG8_SCHED
}
}

#ifndef MK_N_LAUNCHES
#define MK_N_LAUNCHES 1
#endif
constexpr int NWAVES = 8, NTHR = 512, NPHASE = 8;
constexpr int BATCH = 2, T = 8192, D = 1024, M = BATCH * T;
constexpr int DPROJ = 5664, DMIX = 2048;
constexpr int NPN = 3840, NPT = 2048, NWT = NPN + NPT;
constexpr int CN_G = 0, CN_Z = 1024, CN_Q = 2048, CN_K = 2560, CN_B = 3072, CN_C = 3328, CN_GL = 3584, CN_DT = 3600, CN_PAD = 3616;
constexpr float EPS = 1e-6f;
constexpr size_t MiB = 1u << 20;
constexpr size_t WS_ADA = 0, WS_SDEC = 32 * 1024, WS_GDEC = 64 * 1024;
constexpr size_t WS_WOUT = 1 * MiB, WS_WT = 5 * MiB, WS_H = 17 * MiB, WS_PN = 49 * MiB, WS_PT = 169 * MiB, WS_END = 233 * MiB;
constexpr size_t WS_SS = 5 * MiB;
constexpr size_t WS_BAR = 640 * 1024, BAR_BYTES = 16 * 1024;
constexpr int LDS_BAR_OFF = 140000;
constexpr int LDS_BYTES = 147456;

#define LAS __attribute__((address_space(3)))
typedef unsigned short bf16_t;
typedef short bf16x8 __attribute__((ext_vector_type(8)));
typedef float f32x4 __attribute__((ext_vector_type(4)));
typedef float f32x2 __attribute__((ext_vector_type(2)));
typedef unsigned u32x4 __attribute__((ext_vector_type(4)));
typedef unsigned u32x2 __attribute__((ext_vector_type(2)));
#define LDS_WAIT() asm volatile("s_waitcnt lgkmcnt(0)" ::: "memory")

__device__ __forceinline__ float bf2f(unsigned b) { return __uint_as_float(b << 16); }
__device__ __forceinline__ float bflo(unsigned u) { return __uint_as_float(u << 16); }
__device__ __forceinline__ float bfhi(unsigned u) { return __uint_as_float(u & 0xffff0000u); }
typedef __bf16 bf16x2_t __attribute__((ext_vector_type(2)));
__device__ __forceinline__ unsigned pk2(float lo, float hi) { const f32x2 v = {lo, hi}; const bf16x2_t b = __builtin_convertvector(v, bf16x2_t); return __builtin_bit_cast(unsigned, b); }
__device__ __forceinline__ bf16_t f2bf(float f) { const __bf16 b = (__bf16)f; return __builtin_bit_cast(unsigned short, b); }
__device__ __forceinline__ void st_wt8(void* p, u32x2 v) { __hip_atomic_store((unsigned long long*)p, ((unsigned long long)v.y << 32) | v.x, __ATOMIC_RELAXED, __HIP_MEMORY_SCOPE_AGENT); }
__device__ __forceinline__ void st_wt4(void* p, unsigned v) { __hip_atomic_store((unsigned*)p, v, __ATOMIC_RELAXED, __HIP_MEMORY_SCOPE_AGENT); }
__device__ __forceinline__ float silu_f(float x) { return x * __builtin_amdgcn_rcpf(1.f + __expf(-x)); }
__device__ __forceinline__ float wave_sum(float v) {
#pragma unroll
    for (int o = 1; o < 64; o <<= 1) v += __shfl_xor(v, o);
    return v;
}
__device__ __forceinline__ f32x4 mma16(bf16x8 arow, bf16x8 brow, f32x4 acc) { return __builtin_amdgcn_mfma_f32_16x16x32_bf16(brow, arow, acc, 0, 0, 0); }
__device__ __forceinline__ bf16x8 lfrag(const LAS bf16_t* base, int row, int pitch, int k) { return *(const LAS bf16x8*)(base + row * pitch + k); }
__device__ __forceinline__ bf16x8 gfrag(const bf16_t* p) { return *(const bf16x8*)p; }

__device__ __forceinline__ bf16_t* sg_item(unsigned char* sg, int item) { return (bf16_t*)sg + (size_t)item * 32768; }
__device__ __forceinline__ int win_dest(int n) {
    if (n < 512) return CN_Q + n;
    if (n < 1024) return CN_K + (n - 512);
    if (n < 2048) return NPN + (n - 1024);
    if (n < 3072) return CN_G + (n - 2048);
    if (n < 3088) return CN_GL + (n - 3072);
    if (n < 4112) return CN_Z + (n - 3088);
    if (n < 5136) return NPN + 1024 + (n - 4112);
    if (n < 5392) return CN_B + (n - 5136);
    if (n < 5648) return CN_C + (n - 5392);
    return CN_DT + (n - 5648);
}

template <bool WIN>
__device__ __forceinline__ void transpose_item(const float* __restrict__ W, int K, int N, bf16_t* __restrict__ WT, LAS float* scr, int item, int lane) {
    const int nblk = N / 32, kb = item / nblk, nb = item % nblk, k0 = 64 * kb, n0 = 32 * nb;
#pragma unroll 8
    for (int i = 0; i < 32; ++i) { const int kk = 2 * i + (lane >> 5); scr[kk * 33 + (lane & 31)] = W[(size_t)(k0 + kk) * N + n0 + (lane & 31)]; }
    LDS_WAIT();
    const int c = lane & 7;
#pragma unroll
    for (int j = 0; j < 4; ++j) {
        const int n = (lane >> 3) + 8 * j; const LAS float* s = scr + (8 * c) * 33 + n;
        u32x4 o; o.x = pk2(s[0 * 33], s[1 * 33]); o.y = pk2(s[2 * 33], s[3 * 33]); o.z = pk2(s[4 * 33], s[5 * 33]); o.w = pk2(s[6 * 33], s[7 * 33]);
        const int dr = WIN ? win_dest(n0 + n) : (n0 + n);
        *(u32x4*)(WT + (size_t)dr * K + k0 + 8 * c) = o;
    }
    LDS_WAIT();
}

__device__ __forceinline__ void phase0(LAS unsigned char* lds, const float* __restrict__ c_in, const float* __restrict__ ada_w, const float* __restrict__ ada_b,
                                       const float* __restrict__ w_in, const float* __restrict__ w_out, unsigned char* ws, int tid, int wave, int lane) {
    bf16_t* WT = (bf16_t*)(ws + WS_WT); bf16_t* WOT = (bf16_t*)(ws + WS_WOUT); float* ada = (float*)(ws + WS_ADA);
    const int G = gridDim.x;
    for (int it = blockIdx.x; it < 192; it += G) {
        LAS float* red = (LAS float*)(lds + 8 * 16384);
        const int n0 = 16 * it, kk = lane >> 4, nn = lane & 15;
        float a0 = 0.f, a1 = 0.f;
#pragma unroll 8
        for (int i = 0; i < 32; ++i) {
            const int k = 128 * wave + 4 * i + kk;
            const float wv = ada_w[(size_t)k * 3072 + n0 + nn];
            a0 += silu_f(c_in[k]) * wv; a1 += silu_f(c_in[D + k]) * wv;
        }
        a0 += __shfl_xor(a0, 16); a0 += __shfl_xor(a0, 32); a1 += __shfl_xor(a1, 16); a1 += __shfl_xor(a1, 32);
        if (lane < 16) { red[(wave * 2 + 0) * 16 + nn] = a0; red[(wave * 2 + 1) * 16 + nn] = a1; }
        __syncthreads();
        if (tid < 32) { const int b = tid >> 4, n = tid & 15; float s = ada_b[n0 + n];
#pragma unroll
            for (int w = 0; w < 8; ++w) s += red[(w * 2 + b) * 16 + n];
            ada[b * 3072 + n0 + n] = s; }
        __syncthreads();
    }
    LAS float* scr = (LAS float*)(lds + wave * 16384);
    const int gw = blockIdx.x * NWAVES + wave, NGW = G * NWAVES;
    constexpr int I_IN = (D / 64) * (DPROJ / 32), I_OUT = (DMIX / 64) * (D / 32);
    for (int it = gw; it < I_IN + I_OUT; it += NGW) {
        if (it < I_IN) transpose_item<true>(w_in, D, DPROJ, WT, scr, it, lane);
        else transpose_item<false>(w_out, DMIX, D, WOT, scr, it - I_IN, lane);
    }
#ifdef POISON_SS
    { const int gt = blockIdx.x * NTHR + tid, GT = G * NTHR; u32x4* z = (u32x4*)(ws + POISON_SS);
      for (int i = gt; i < (int)(32 * MiB / 16); i += GT) z[i] = (u32x4){0x7fc07fc0u, 0x7fc07fc0u, 0x7fc07fc0u, 0x7fc07fc0u}; }
#endif
    { const int gt = blockIdx.x * NTHR + tid, GT = G * NTHR; u32x4* z = (u32x4*)(WT + (size_t)CN_PAD * D);
      for (int i = gt; i < (NPN - CN_PAD) * D / 8; i += GT) z[i] = (u32x4){0u, 0u, 0u, 0u}; }
}

__device__ __forceinline__ void phase1(const float* __restrict__ x, const float* __restrict__ pre_w, const unsigned char* ws_c, bf16_t* __restrict__ H, int wave, int lane) {
    const float* ada = (const float*)(ws_c + WS_ADA);
    const int gw = blockIdx.x * NWAVES + wave, NGW = gridDim.x * NWAVES;
    for (int m = gw; m < M; m += NGW) {
        const int b = m >> 13;
        const f32x4* xr = (const f32x4*)(x + (size_t)m * D) + lane;
        f32x4 v[4]; float s = 0.f;
#pragma unroll
        for (int j = 0; j < 4; ++j) { v[j] = xr[64 * j]; s += (v[j].x * v[j].x + v[j].y * v[j].y) + (v[j].z * v[j].z + v[j].w * v[j].w); }
        const float rstd = rsqrtf(wave_sum(s) * (1.f / D) + EPS);
        unsigned long long* o8 = (unsigned long long*)(H + (size_t)m * D) + lane;
#pragma unroll
        for (int j = 0; j < 4; ++j) {
            const int col = 4 * lane + 256 * j;
            const f32x4 w = *(const f32x4*)(pre_w + col), sh = *(const f32x4*)(ada + b * 3072 + col), sc = *(const f32x4*)(ada + b * 3072 + 1024 + col);
            const f32x4 hv = (v[j] * rstd) * w * (sc + 1.f) + sh;
            o8[64 * j] = (unsigned long long)pk2(hv.x, hv.y) | ((unsigned long long)pk2(hv.z, hv.w) << 32);
        }
    }
}

constexpr int GL_OFF_GLR = 0, GL_OFF_PART = 4096, GL_OFF_RED = 6144, GL_OFF_A = 8192, GL_OFF_B = 26624, GL_OFF_ATT = 44032;
template <int MODE>
__device__ __forceinline__ void gla_prep(LAS unsigned char* lds, const bf16_t* __restrict__ PN, const float* __restrict__ w2, const float* __restrict__ gbias, float* gdec, int t0, int h, int tid) {
    LAS float* glr = (LAS float*)(lds + GL_OFF_GLR);
    LAS float* part = (LAS float*)(lds + GL_OFF_PART);
    for (int idx = tid; idx < 1024; idx += NTHR) glr[idx] = bf2f(PN[(size_t)(t0 + (idx >> 4)) * NPN + CN_GL + (idx & 15)]);
    const int k = tid & 127, jq = tid >> 7;
    float w[16];
#pragma unroll
    for (int r = 0; r < 16; ++r) w[r] = w2[r * 512 + h * 128 + k];
    const float bias = gbias[h * 128 + k];
    __syncthreads();
    float pre[16]; float run = 0.f;
#pragma unroll
    for (int jj = 0; jj < 16; ++jj) {
        const LAS f32x4* g4 = (const LAS f32x4*)(glr + (jq * 16 + jj) * 16);
        float xg = bias;
#pragma unroll
        for (int r4 = 0; r4 < 4; ++r4) { const f32x4 gv = g4[r4]; xg += gv.x * w[4 * r4]; xg += gv.y * w[4 * r4 + 1]; xg += gv.z * w[4 * r4 + 2]; xg += gv.w * w[4 * r4 + 3]; }
        const float ls = fminf(xg, 0.f) - __logf(1.f + __expf(-fabsf(xg)));
        run += ls * (1.f / 16.f);
        pre[jj] = run;
    }
    part[jq * 128 + k] = run;
    __syncthreads();
    float off = 0.f, tot = 0.f;
#pragma unroll
    for (int q = 0; q < 4; ++q) { const float p = part[q * 128 + k]; off += (q < jq) ? p : 0.f; tot += p; }
    if (MODE == 0) {
        LAS bf16_t* KeT = (LAS bf16_t*)(lds + GL_OFF_A);
        const bf16_t* kp = PN + (size_t)(t0 + jq * 16) * NPN + CN_K + h * 128 + k;
#pragma unroll
        for (int jj = 0; jj < 16; jj += 2) {
            const float k0 = bf2f(kp[(size_t)jj * NPN]), k1 = bf2f(kp[(size_t)(jj + 1) * NPN]);
            const float e0 = __expf(tot - (off + pre[jj])), e1 = __expf(tot - (off + pre[jj + 1]));
            *(LAS unsigned*)(KeT + k * 72 + jq * 16 + jj) = pk2(k0 * e0, k1 * e1);
        }
        if (jq == 0) gdec[k] = __expf(tot);
    } else {
        LAS bf16_t* Qd = (LAS bf16_t*)(lds + GL_OFF_A); LAS bf16_t* Kd = (LAS bf16_t*)(lds + GL_OFF_B);
        const bf16_t* qp = PN + (size_t)(t0 + jq * 16) * NPN + CN_Q + h * 128 + k;
        const bf16_t* kp = PN + (size_t)(t0 + jq * 16) * NPN + CN_K + h * 128 + k;
#pragma unroll
        for (int jj = 0; jj < 16; ++jj) {
            const float bb = off + pre[jj];
            const float qv = bf2f(qp[(size_t)jj * NPN]) * 0.08838834764831845f * __expf(bb);
            const float kv = bf2f(kp[(size_t)jj * NPN]) * __expf(-bb);
            Qd[(jq * 16 + jj) * 136 + k] = f2bf(qv); Kd[(jq * 16 + jj) * 136 + k] = f2bf(kv);
        }
    }
}

__device__ __forceinline__ void gla_state_item(LAS unsigned char* lds, const bf16_t* __restrict__ PN, const bf16_t* __restrict__ PT, const float* __restrict__ w2, const float* __restrict__ gbias,
                                               float* gdec, unsigned char* ws, int item, int tid, int wave, int lane) {
    const int h = item & 3, t0 = (item >> 2) * 64;
    gla_prep<0>(lds, PN, w2, gbias, gdec + (size_t)item * 128, t0, h, tid);
    const int fr = lane & 15, fq = lane >> 4;
    bf16x8 av[2][2];
#pragma unroll
    for (int mt = 0; mt < 2; ++mt)
#pragma unroll
        for (int ks = 0; ks < 2; ++ks) av[mt][ks] = gfrag(PT + (size_t)(h * 256 + wave * 32 + mt * 16 + fr) * M + t0 + ks * 32 + 8 * fq);
    __syncthreads();
    const LAS bf16_t* KeT = (const LAS bf16_t*)(lds + GL_OFF_A);
    f32x4 acc[2][8];
#pragma unroll
    for (int mt = 0; mt < 2; ++mt)
#pragma unroll
        for (int nt = 0; nt < 8; ++nt) acc[mt][nt] = (f32x4){0.f, 0.f, 0.f, 0.f};
#pragma unroll
    for (int nt = 0; nt < 8; ++nt)
#pragma unroll
        for (int ks = 0; ks < 2; ++ks) {
            const bf16x8 bfg = lfrag(KeT, nt * 16 + fr, 72, ks * 32 + 8 * fq);
#pragma unroll
            for (int mt = 0; mt < 2; ++mt) acc[mt][nt] = mma16(av[mt][ks], bfg, acc[mt][nt]);
        }
    bf16_t* So = sg_item(ws, item);
#pragma unroll
    for (int mt = 0; mt < 2; ++mt)
#pragma unroll
        for (int nt = 0; nt < 8; ++nt) {
            const int v = wave * 32 + mt * 16 + fr, kk = nt * 16 + 4 * fq;
            u32x2 o; o.x = pk2(acc[mt][nt][0], acc[mt][nt][1]); o.y = pk2(acc[mt][nt][2], acc[mt][nt][3]);
            *(u32x2*)(So + v * 128 + kk) = o;
        }
    __syncthreads();
}

__device__ __forceinline__ void gla_out_item(LAS unsigned char* lds, bf16_t* __restrict__ PN, const bf16_t* __restrict__ PT, const float* __restrict__ w2, const float* __restrict__ gbias,
                                             const float* __restrict__ gnw, unsigned char* ws, int item, int tid, int wave, int lane) {
    const int h = item & 3, t0 = (item >> 2) * 64;
    gla_prep<1>(lds, PN, w2, gbias, nullptr, t0, h, tid);
    __syncthreads();
    const int fr = lane & 15, fq = lane >> 4;
    const LAS bf16_t* Qd = (const LAS bf16_t*)(lds + GL_OFF_A); const LAS bf16_t* Kd = (const LAS bf16_t*)(lds + GL_OFF_B);
    LAS bf16_t* att = (LAS bf16_t*)(lds + GL_OFF_ATT);
    {
        const int mt = wave >> 1;
#pragma unroll
        for (int e = 0; e < 2; ++e) {
            const int nt = (wave & 1) * 2 + e;
            f32x4 a = (f32x4){0.f, 0.f, 0.f, 0.f};
            if (nt <= mt) {
#pragma unroll
                for (int ks = 0; ks < 4; ++ks) a = mma16(lfrag(Qd, mt * 16 + fr, 136, ks * 32 + 8 * fq), lfrag(Kd, nt * 16 + fr, 136, ks * 32 + 8 * fq), a);
            }
            const int i = mt * 16 + fr, j0 = nt * 16 + 4 * fq;
            const float v0 = (j0 + 0 <= i) ? a[0] : 0.f, v1 = (j0 + 1 <= i) ? a[1] : 0.f, v2 = (j0 + 2 <= i) ? a[2] : 0.f, v3 = (j0 + 3 <= i) ? a[3] : 0.f;
            u32x2 o; o.x = pk2(v0, v1); o.y = pk2(v2, v3);
            *(LAS u32x2*)(att + i * 72 + j0) = o;
        }
    }
    __syncthreads();
    f32x4 acc[4][2];
#pragma unroll
    for (int mt = 0; mt < 4; ++mt)
#pragma unroll
        for (int nt = 0; nt < 2; ++nt) acc[mt][nt] = (f32x4){0.f, 0.f, 0.f, 0.f};
#pragma unroll
    for (int ks = 0; ks < 2; ++ks) {
        bf16x8 bv[2];
#pragma unroll
        for (int nt = 0; nt < 2; ++nt) bv[nt] = gfrag(PT + (size_t)(h * 256 + wave * 32 + nt * 16 + fr) * M + t0 + ks * 32 + 8 * fq);
#pragma unroll
        for (int mt = 0; mt < 4; ++mt) {
            if (ks == 1 && mt < 2) continue;
            const bf16x8 af = lfrag(att, mt * 16 + fr, 72, ks * 32 + 8 * fq);
#pragma unroll
            for (int nt = 0; nt < 2; ++nt) acc[mt][nt] = mma16(af, bv[nt], acc[mt][nt]);
        }
    }
    const bf16_t* Sp = sg_item(ws, item);
#pragma unroll
    for (int ks = 0; ks < 4; ++ks) {
        bf16x8 bs[2];
#pragma unroll
        for (int nt = 0; nt < 2; ++nt) bs[nt] = gfrag(Sp + (wave * 32 + nt * 16 + fr) * 128 + ks * 32 + 8 * fq);
#pragma unroll
        for (int mt = 0; mt < 4; ++mt) {
            const bf16x8 af = lfrag(Qd, mt * 16 + fr, 136, ks * 32 + 8 * fq);
#pragma unroll
            for (int nt = 0; nt < 2; ++nt) acc[mt][nt] = mma16(af, bs[nt], acc[mt][nt]);
        }
    }
    LAS float* red = (LAS float*)(lds + GL_OFF_RED);
#pragma unroll
    for (int mt = 0; mt < 4; ++mt) {
        float s = 0.f;
#pragma unroll
        for (int nt = 0; nt < 2; ++nt) { const f32x4 a = acc[mt][nt]; s += (a[0] * a[0] + a[1] * a[1]) + (a[2] * a[2] + a[3] * a[3]); }
        s += __shfl_xor(s, 16); s += __shfl_xor(s, 32);
        if (fq == 0) red[wave * 64 + mt * 16 + fr] = s;
    }
    __syncthreads();
#pragma unroll
    for (int mt = 0; mt < 4; ++mt) {
        const int i = mt * 16 + fr;
        float tot = 0.f;
#pragma unroll
        for (int w = 0; w < 8; ++w) tot += red[w * 64 + i];
        const float rstd = rsqrtf(tot * (1.f / 256.f) + EPS);
#pragma unroll
        for (int nt = 0; nt < 2; ++nt) {
            const int v0 = wave * 32 + nt * 16 + 4 * fq;
            const f32x4 nw = *(const f32x4*)(gnw + v0);
            bf16_t* gp = PN + (size_t)(t0 + i) * NPN + CN_G + h * 256 + v0;
            const u32x2 gr = *(const u32x2*)gp;
            const f32x4 a = acc[mt][nt];
            u32x2 o;
            o.x = pk2(a[0] * rstd * nw[0] * silu_f(bflo(gr.x)), a[1] * rstd * nw[1] * silu_f(bfhi(gr.x)));
            o.y = pk2(a[2] * rstd * nw[2] * silu_f(bflo(gr.y)), a[3] * rstd * nw[3] * silu_f(bfhi(gr.y)));
            *(u32x2*)gp = o;
        }
    }
    __syncthreads();
}

constexpr int SS_OFF_DT = 0, SS_OFF_AC = 4096;
constexpr int S3_OFF_BT = 8192, S3_OFF_XT = 43008;
constexpr int S5_OFF_CN = 8192, S5_OFF_BN = 43008, S5_OFF_WH = 77824, S5_OFF_XT = 112640;

__device__ __forceinline__ void ssd_dt_prep(LAS unsigned char* lds, const bf16_t* __restrict__ PN, const float* __restrict__ dt_bias, const float* __restrict__ a_log, int t0, int g, int tid, int wave, int lane) {
    LAS float* dtL = (LAS float*)(lds + SS_OFF_DT); LAS float* acL = (LAS float*)(lds + SS_OFF_AC);
    const int j = tid & 127, hq = tid >> 7;
#pragma unroll
    for (int e = 0; e < 2; ++e) {
        const int hh = hq * 2 + e, hd = g * 8 + hh;
        const float raw = bf2f(PN[(size_t)(t0 + j) * NPN + CN_DT + hd]) + dt_bias[hd];
        const float dt = raw > 20.f ? raw : log1pf(__expf(raw));
        dtL[hh * 128 + j] = dt; acL[hh * 128 + j] = -dt * __expf(a_log[hd]);
    }
    __syncthreads();
    {
        const float v0 = acL[wave * 128 + 2 * lane], v1 = acL[wave * 128 + 2 * lane + 1];
        float s = v0 + v1;
#pragma unroll
        for (int o = 1; o < 64; o <<= 1) { const float t = __shfl_up(s, o); s += (lane >= o) ? t : 0.f; }
        const float ex = s - (v0 + v1);
        acL[wave * 128 + 2 * lane] = ex + v0; acL[wave * 128 + 2 * lane + 1] = ex + v0 + v1;
    }
    __syncthreads();
}
__device__ __forceinline__ void conv8_nat(const bf16_t* __restrict__ PN, const float* __restrict__ cw, const float* __restrict__ cb, int tok, int pos, int col, int ch0, float (&out)[8]) {
    { const f32x4 b0 = *(const f32x4*)(cb + ch0), b1 = *(const f32x4*)(cb + ch0 + 4);
      out[0] = b0[0]; out[1] = b0[1]; out[2] = b0[2]; out[3] = b0[3]; out[4] = b1[0]; out[5] = b1[1]; out[6] = b1[2]; out[7] = b1[3]; }
#pragma unroll
    for (int tp = 0; tp < 4; ++tp) {
        {
            const bool ok = (pos - 3 + tp) >= 0;
            u32x4 raw = *(const u32x4*)(PN + (size_t)(ok ? tok - 3 + tp : tok) * NPN + col);
            raw.x = ok ? raw.x : 0u; raw.y = ok ? raw.y : 0u; raw.z = ok ? raw.z : 0u; raw.w = ok ? raw.w : 0u;
            const f32x4 w0 = *(const f32x4*)(cw + tp * 1536 + ch0), w1 = *(const f32x4*)(cw + tp * 1536 + ch0 + 4);
            out[0] += w0[0] * bflo(raw.x); out[1] += w0[1] * bfhi(raw.x); out[2] += w0[2] * bflo(raw.y); out[3] += w0[3] * bfhi(raw.y);
            out[4] += w1[0] * bflo(raw.z); out[5] += w1[1] * bfhi(raw.z); out[6] += w1[2] * bflo(raw.w); out[7] += w1[3] * bfhi(raw.w);
        }
    }
#pragma unroll
    for (int e = 0; e < 8; ++e) out[e] = silu_f(out[e]);
}
__device__ __forceinline__ void conv8_tr(const bf16_t* __restrict__ PT, const float* __restrict__ cw, const float* __restrict__ cb, int row, int tcol, bool has_prev, int ch, float (&out)[8]) {
    const u32x4 cur = *(const u32x4*)(PT + (size_t)row * M + tcol);
    u32x4 prv = *(const u32x4*)(PT + (size_t)row * M + tcol - (has_prev ? 8 : 0));
    prv.z = has_prev ? prv.z : 0u; prv.w = has_prev ? prv.w : 0u;
    float u[11];
    u[0] = bfhi(prv.z); u[1] = bflo(prv.w); u[2] = bfhi(prv.w);
    u[3] = bflo(cur.x); u[4] = bfhi(cur.x); u[5] = bflo(cur.y); u[6] = bfhi(cur.y); u[7] = bflo(cur.z); u[8] = bfhi(cur.z); u[9] = bflo(cur.w); u[10] = bfhi(cur.w);
    const float w0 = cw[ch], w1 = cw[1536 + ch], w2 = cw[2 * 1536 + ch], w3 = cw[3 * 1536 + ch], bias = cb[ch];
#pragma unroll
    for (int e = 0; e < 8; ++e) out[e] = silu_f(bias + w0 * u[e] + w1 * u[e + 1] + w2 * u[e + 2] + w3 * u[e + 3]);
}

__device__ __forceinline__ void ssd_state_item(LAS unsigned char* lds, const bf16_t* __restrict__ PN, const bf16_t* __restrict__ PT, const float* __restrict__ cw, const float* __restrict__ cb,
                                               const float* __restrict__ dt_bias, const float* __restrict__ a_log, float* sdec, bf16_t* SS, int item, int tid, int wave, int lane) {
    const int g = item & 1, bc = item >> 1, c = bc & 63, t0 = bc * 128;
    ssd_dt_prep(lds, PN, dt_bias, a_log, t0, g, tid, wave, lane);
    const LAS float* dtL = (const LAS float*)(lds + SS_OFF_DT); const LAS float* acL = (const LAS float*)(lds + SS_OFF_AC);
    LAS bf16_t* BT = (LAS bf16_t*)(lds + S3_OFF_BT); LAS bf16_t* XT = (LAS bf16_t*)(lds + S3_OFF_XT);
    for (int idx = tid; idx < 2048; idx += NTHR) {
        const int j = idx & 127, cc = idx >> 7;
        float o[8];
        conv8_nat(PN, cw, cb, t0 + j, c * 128 + j, CN_B + g * 128 + 8 * cc, 1024 + g * 128 + 8 * cc, o);
#pragma unroll
        for (int e = 0; e < 8; ++e) BT[(8 * cc + e) * 136 + j] = f2bf(o[e]);
    }
    if (tid < 8) sdec[bc * 16 + g * 8 + tid] = __expf(acL[tid * 128 + 127]);
    __syncthreads();
    const int fr = lane & 15, fq = lane >> 4;
#pragma unroll 1
    for (int hh = 0; hh < 8; ++hh) {
        const int hd = g * 8 + hh;
        const float alast = acL[hh * 128 + 127];
        for (int idx = tid; idx < 1024; idx += NTHR) {
            const int jc = idx & 15, p = idx >> 4;
            float o[8];
            conv8_tr(PT, cw, cb, 1024 + hd * 64 + p, t0 + 8 * jc, (c * 128 + 8 * jc) > 0, hd * 64 + p, o);
#pragma unroll
            for (int e = 0; e < 8; ++e) { const int j = 8 * jc + e; o[e] *= dtL[hh * 128 + j] * __expf(alast - acL[hh * 128 + j]); }
            u32x4 pk; pk.x = pk2(o[0], o[1]); pk.y = pk2(o[2], o[3]); pk.z = pk2(o[4], o[5]); pk.w = pk2(o[6], o[7]);
            *(LAS u32x4*)(XT + p * 136 + 8 * jc) = pk;
        }
        __syncthreads();
        const int mt = wave & 3, nh = wave >> 2;
        f32x4 acc[4];
#pragma unroll
        for (int n4 = 0; n4 < 4; ++n4) acc[n4] = (f32x4){0.f, 0.f, 0.f, 0.f};
#pragma unroll
        for (int ks = 0; ks < 4; ++ks) {
            const bf16x8 af = lfrag(XT, mt * 16 + fr, 136, ks * 32 + 8 * fq);
#pragma unroll
            for (int n4 = 0; n4 < 4; ++n4) acc[n4] = mma16(af, lfrag(BT, (nh * 4 + n4) * 16 + fr, 136, ks * 32 + 8 * fq), acc[n4]);
        }
        bf16_t* So = SS + (size_t)(bc * 16 + hd) * 8192;
#pragma unroll
        for (int n4 = 0; n4 < 4; ++n4) {
            u32x2 o; o.x = pk2(acc[n4][0], acc[n4][1]); o.y = pk2(acc[n4][2], acc[n4][3]);
            *(u32x2*)(So + (mt * 16 + fr) * 128 + (nh * 4 + n4) * 16 + 4 * fq) = o;
        }
        __syncthreads();
    }
}

__device__ __forceinline__ void ssd_out_item(LAS unsigned char* lds, bf16_t* __restrict__ PN, const bf16_t* __restrict__ PT, const float* __restrict__ cw, const float* __restrict__ cb,
                                             const float* __restrict__ dt_bias, const float* __restrict__ a_log, const float* __restrict__ d_skip, const float* __restrict__ snw,
                                             const bf16_t* __restrict__ SS, int item, int tid, int wave, int lane) {
    const int g = item & 1, bc = item >> 1, c = bc & 63, t0 = bc * 128;
    ssd_dt_prep(lds, PN, dt_bias, a_log, t0, g, tid, wave, lane);
    const LAS float* dtL = (const LAS float*)(lds + SS_OFF_DT); const LAS float* acL = (const LAS float*)(lds + SS_OFF_AC);
    LAS bf16_t* Cn = (LAS bf16_t*)(lds + S5_OFF_CN); LAS bf16_t* Bn = (LAS bf16_t*)(lds + S5_OFF_BN);
    LAS bf16_t* Wh = (LAS bf16_t*)(lds + S5_OFF_WH); LAS bf16_t* XT = (LAS bf16_t*)(lds + S5_OFF_XT);
    for (int idx = tid; idx < 4096; idx += NTHR) {
        const int cc = idx & 15, j = (idx >> 4) & 127, which = idx >> 11;
        float o[8];
        conv8_nat(PN, cw, cb, t0 + j, c * 128 + j, (which ? CN_C : CN_B) + g * 128 + 8 * cc, 1024 + which * 256 + g * 128 + 8 * cc, o);
        u32x4 pk; pk.x = pk2(o[0], o[1]); pk.y = pk2(o[2], o[3]); pk.z = pk2(o[4], o[5]); pk.w = pk2(o[6], o[7]);
        *(LAS u32x4*)((which ? Cn : Bn) + j * 136 + 8 * cc) = pk;
    }
    __syncthreads();
    const int fr = lane & 15, fq = lane >> 4;
    bf16x8 cf[4];
#pragma unroll
    for (int ks = 0; ks < 4; ++ks) cf[ks] = lfrag(Cn, wave * 16 + fr, 136, ks * 32 + 8 * fq);
    f32x4 cbv[8];
#pragma unroll
    for (int nt = 0; nt < 8; ++nt) {
        cbv[nt] = (f32x4){0.f, 0.f, 0.f, 0.f};
        if (nt <= wave) {
#pragma unroll
            for (int ks = 0; ks < 4; ++ks) cbv[nt] = mma16(cf[ks], lfrag(Bn, nt * 16 + fr, 136, ks * 32 + 8 * fq), cbv[nt]);
        }
    }
    const int i = wave * 16 + fr;
    float ss = 0.f;
#pragma unroll 1
    for (int hh = 0; hh < 8; ++hh) {
        const int hd = g * 8 + hh;
        for (int idx = tid; idx < 1024; idx += NTHR) {
            const int jc = idx & 15, p = idx >> 4;
            float o[8];
            conv8_tr(PT, cw, cb, 1024 + hd * 64 + p, t0 + 8 * jc, (c * 128 + 8 * jc) > 0, hd * 64 + p, o);
            u32x4 pk; pk.x = pk2(o[0], o[1]); pk.y = pk2(o[2], o[3]); pk.z = pk2(o[4], o[5]); pk.w = pk2(o[6], o[7]);
            *(LAS u32x4*)(XT + p * 136 + 8 * jc) = pk;
        }
        const float aci = acL[hh * 128 + i];
#pragma unroll
        for (int nt = 0; nt < 8; ++nt) {
            if (nt <= (wave | 1)) {
                const int j0 = nt * 16 + 4 * fq;
                const f32x4 acj = *(const LAS f32x4*)(acL + hh * 128 + j0), dtj = *(const LAS f32x4*)(dtL + hh * 128 + j0);
                float v[4];
#pragma unroll
                for (int r = 0; r < 4; ++r) { const float t = cbv[nt][r] * __expf(aci - acj[r]) * dtj[r]; v[r] = (j0 + r <= i) ? t : 0.f; }
                u32x2 o; o.x = pk2(v[0], v[1]); o.y = pk2(v[2], v[3]);
                *(LAS u32x2*)(Wh + i * 136 + j0) = o;
            }
        }
        __syncthreads();
        f32x4 y1[4], y2[4];
#pragma unroll
        for (int nt = 0; nt < 4; ++nt) { y1[nt] = (f32x4){0.f, 0.f, 0.f, 0.f}; y2[nt] = (f32x4){0.f, 0.f, 0.f, 0.f}; }
#ifndef SSD_NO_Y1
#pragma unroll
        for (int ks = 0; ks < 4; ++ks) {
            if (ks <= (wave >> 1)) {
                const bf16x8 af = lfrag(Wh, wave * 16 + fr, 136, ks * 32 + 8 * fq);
#pragma unroll
                for (int nt = 0; nt < 4; ++nt) y1[nt] = mma16(af, lfrag(XT, nt * 16 + fr, 136, ks * 32 + 8 * fq), y1[nt]);
            }
        }
#endif
        const bf16_t* Sp = SS + (size_t)(bc * 16 + hd) * 8192;
#ifndef SSD_NO_Y2
#pragma unroll
        for (int ks = 0; ks < 4; ++ks)
#pragma unroll
            for (int nt = 0; nt < 4; ++nt) y2[nt] = mma16(cf[ks], gfrag(Sp + (nt * 16 + fr) * 128 + ks * 32 + 8 * fq), y2[nt]);
#endif
        const float eai = __expf(aci), Dh = d_skip[hd];
#pragma unroll
        for (int nt = 0; nt < 4; ++nt) {
            const int p0 = nt * 16 + 4 * fq;
            bf16_t* zp = PN + (size_t)(t0 + i) * NPN + CN_Z + hd * 64 + p0;
            const u32x2 zr = *(const u32x2*)zp;
            float yz[4];
#pragma unroll
            for (int r = 0; r < 4; ++r) {
                const float xv = bf2f(XT[(p0 + r) * 136 + i]);
                const float y = y1[nt][r] + eai * y2[nt][r] + Dh * xv;
                const float z = (r == 0) ? bflo(zr.x) : (r == 1) ? bfhi(zr.x) : (r == 2) ? bflo(zr.y) : bfhi(zr.y);
                yz[r] = y * silu_f(z);
                ss += yz[r] * yz[r];
            }
            u32x2 yo; yo.x = pk2(yz[0], yz[1]); yo.y = pk2(yz[2], yz[3]);
            *(u32x2*)zp = yo;
        }
        __syncthreads();
    }
    ss += __shfl_xor(ss, 16); ss += __shfl_xor(ss, 32);
    const float rstd = rsqrtf(ss * (1.f / 512.f) + EPS);
#pragma unroll 2
    for (int hh = 0; hh < 8; ++hh)
#pragma unroll
        for (int nt = 0; nt < 4; ++nt) {
            const int p0 = nt * 16 + 4 * fq, hd = g * 8 + hh;
            const f32x4 nw = *(const f32x4*)(snw + g * 512 + hh * 64 + p0);
            bf16_t* zp = PN + (size_t)(t0 + i) * NPN + CN_Z + hd * 64 + p0;
            const u32x2 yv = *(const u32x2*)zp;
            u32x2 o;
            o.x = pk2(bflo(yv.x) * rstd * nw[0], bfhi(yv.x) * rstd * nw[1]);
            o.y = pk2(bflo(yv.y) * rstd * nw[2], bfhi(yv.y) * rstd * nw[3]);
            *(u32x2*)zp = o;
        }
    __syncthreads();
}

__device__ __forceinline__ void scan_gla(unsigned char* ws, const float* __restrict__ gdec, int tid) {
    const int gt = blockIdx.x * NTHR + tid, GT = gridDim.x * NTHR;
    for (int w = gt; w < 8 * 16384; w += GT) {
        const int bh = w >> 14, e2 = w & 16383, b = bh >> 2, h = bh & 3, kk = (2 * e2) & 127;
        bf16_t* p = sg_item(ws, b * 512 + h) + 2 * e2;
        const float* dp = gdec + (size_t)(b * 512 + h) * 128 + kk;
        float s0 = 0.f, s1 = 0.f;
        for (int n0 = 0; n0 < 128; n0 += 8) {
            unsigned u[8]; f32x2 d[8];
#pragma unroll
            for (int q = 0; q < 8; ++q) { u[q] = *(const unsigned*)(p + (size_t)(n0 + q) * 131072); d[q] = *(const f32x2*)(dp + (n0 + q) * 512); }
#pragma unroll
            for (int q = 0; q < 8; ++q) { *(unsigned*)(p + (size_t)(n0 + q) * 131072) = pk2(s0, s1); s0 = s0 * d[q].x + bflo(u[q]); s1 = s1 * d[q].y + bfhi(u[q]); }
        }
    }
}
__device__ __forceinline__ void scan_ssd(bf16_t* SS, const float* __restrict__ sdec, int tid) {
    const int gt = blockIdx.x * NTHR + tid, GT = gridDim.x * NTHR;
    for (int w = gt; w < 32 * 4096; w += GT) {
        const int bh = w >> 12, e2 = w & 4095, b = bh >> 4, h = bh & 15;
        bf16_t* p = SS + (size_t)(b * 1024 + h) * 8192 + 2 * e2;
        const float* dp = sdec + b * 1024 + h;
        float s0 = 0.f, s1 = 0.f;
        for (int c0 = 0; c0 < 64; c0 += 8) {
            unsigned u[8]; float d[8];
#pragma unroll
            for (int q = 0; q < 8; ++q) { u[q] = *(const unsigned*)(p + (size_t)(c0 + q) * 131072); d[q] = dp[(c0 + q) * 16]; }
#pragma unroll
            for (int q = 0; q < 8; ++q) { *(unsigned*)(p + (size_t)(c0 + q) * 131072) = pk2(s0, s1); s0 = s0 * d[q] + bflo(u[q]); s1 = s1 * d[q] + bfhi(u[q]); }
        }
    }
}

__device__ __forceinline__ void phase7(const float* __restrict__ x, const bf16_t* __restrict__ MX, const float* __restrict__ post_w, const unsigned char* ws_c, float* __restrict__ out, int wave, int lane) {
    const float* ada = (const float*)(ws_c + WS_ADA);
    const int gw = blockIdx.x * NWAVES + wave, NGW = gridDim.x * NWAVES;
    for (int m = gw; m < M; m += NGW) {
        const int b = m >> 13;
        float v[16]; float s = 0.f;
#pragma unroll
        for (int jj = 0; jj < 2; ++jj) {
            const u32x4 r = *(const u32x4*)(MX + (size_t)m * D + 512 * jj + 8 * lane);
            v[8 * jj + 0] = bflo(r.x); v[8 * jj + 1] = bfhi(r.x); v[8 * jj + 2] = bflo(r.y); v[8 * jj + 3] = bfhi(r.y);
            v[8 * jj + 4] = bflo(r.z); v[8 * jj + 5] = bfhi(r.z); v[8 * jj + 6] = bflo(r.w); v[8 * jj + 7] = bfhi(r.w);
        }
#pragma unroll
        for (int e = 0; e < 16; ++e) s += v[e] * v[e];
        const float rstd = rsqrtf(wave_sum(s) * (1.f / D) + EPS);
#pragma unroll
        for (int jj = 0; jj < 2; ++jj)
#pragma unroll
            for (int q = 0; q < 2; ++q) {
                const int col = 512 * jj + 8 * lane + 4 * q;
                const f32x4 xv = *(const f32x4*)(x + (size_t)m * D + col), gt = *(const f32x4*)(ada + b * 3072 + 2048 + col), pw = *(const f32x4*)(post_w + col);
                f32x4 o;
                o[0] = xv[0] + gt[0] * (v[8 * jj + 4 * q + 0] * rstd * pw[0]); o[1] = xv[1] + gt[1] * (v[8 * jj + 4 * q + 1] * rstd * pw[1]);
                o[2] = xv[2] + gt[2] * (v[8 * jj + 4 * q + 2] * rstd * pw[2]); o[3] = xv[3] + gt[3] * (v[8 * jj + 4 * q + 3] * rstd * pw[3]);
                *(f32x4*)(out + (size_t)m * D + col) = o;
            }
    }
}

#define XB_TMO      128
#define XB_XCNT(j)  (256  + 64 * (j))
#define XB_XSUB(j)  (1280 + 64 * (j))
#define XB_XGEN(j)  (2304 + 64 * (j))
#define XB_TOP      3328
#define XB_TOPGEN   3392
#define XCD_BAR_WORDS 3456
#define XB_SPIN_CAP (1u << 18)

__device__ __forceinline__ unsigned xb_ld(unsigned* p)              { return __hip_atomic_load(p, __ATOMIC_RELAXED, __HIP_MEMORY_SCOPE_AGENT); }
__device__ __forceinline__ unsigned xb_add(unsigned* p, unsigned v) { return __hip_atomic_fetch_add(p, v, __ATOMIC_RELAXED, __HIP_MEMORY_SCOPE_AGENT); }
__device__ __forceinline__ unsigned xb_xcc_id() { return (unsigned)__builtin_amdgcn_s_getreg((3 << 11) | 20) & 0xFu; }
#define XB_SPIN(cond, bar) do { unsigned _sp = 0; while (cond) { __builtin_amdgcn_s_sleep(1); \
    if ((++_sp & 255u) == 0u) { if (xb_ld(&(bar)[XB_TMO])) break; if (_sp > XB_SPIN_CAP) { atomicAdd(&(bar)[XB_TMO], 1u); break; } } } } while (0)

struct XcdBarrier {
    unsigned* bar; unsigned x;
    volatile LAS unsigned* st;
};

__device__ __forceinline__ XcdBarrier xcd_barrier_post(unsigned* bar, volatile LAS unsigned* st) {
    XcdBarrier b; b.bar = bar; b.x = xb_xcc_id(); b.st = st;
    if (threadIdx.x == 0) (void)xb_add(&bar[XB_XCNT(b.x)], 1u);
    return b;
}
__device__ __forceinline__ void xcd_barrier_complete(unsigned* bar, unsigned x, unsigned& nloc, unsigned& nx) {
    const unsigned G = gridDim.x * gridDim.y * gridDim.z;
    unsigned sum, cnt, mine, sp = 0u;
    for (;;) {
        sum = 0u; cnt = 0u; mine = 0u;
#pragma unroll
        for (unsigned j = 0; j < 16; ++j) { const unsigned c = xb_ld(&bar[XB_XCNT(j)]); sum += c; cnt += (c > 0u) ? 1u : 0u; mine = (j == x) ? c : mine; }
        if (sum == G) break;
        __builtin_amdgcn_s_sleep(1);
        if ((++sp & 255u) == 0u) { if (xb_ld(&bar[XB_TMO])) break; if (sp > XB_SPIN_CAP) { atomicAdd(&bar[XB_TMO], 1u); break; } }
    }
    nloc = mine > 0u ? mine : 1u; nx = cnt > 0u ? cnt : 1u;
}

__device__ __forceinline__ void xcd_barrier(const XcdBarrier& b) {
    asm volatile("s_waitcnt vmcnt(0)" ::: "memory");
    __syncthreads();
    if (threadIdx.x == 0) {
        unsigned* bar = b.bar;
        __builtin_amdgcn_s_waitcnt(0);
        unsigned nloc = b.st[0], nx = b.st[1];
        if (nloc == 0u) { xcd_barrier_complete(bar, b.x, nloc, nx); b.st[0] = nloc; b.st[1] = nx; }
        const unsigned old = xb_add(&bar[XB_XSUB(b.x)], 1u);
        const unsigned gen = old / nloc;
        if (old + 1u == (gen + 1u) * nloc) {
            __builtin_amdgcn_fence(__ATOMIC_RELEASE, "agent");
            asm volatile("s_waitcnt vmcnt(0)" ::: "memory");
            const unsigned og = xb_add(&bar[XB_TOP], 1u);
            const unsigned tg = og / nx;
            if (og + 1u == (tg + 1u) * nx) xb_add(&bar[XB_TOPGEN], 1u);
            else XB_SPIN(xb_ld(&bar[XB_TOPGEN]) == tg, bar);
            __builtin_amdgcn_fence(__ATOMIC_ACQUIRE, "agent");
            xb_add(&bar[XB_XGEN(b.x)], 1u);
            asm volatile("s_waitcnt vmcnt(0)" ::: "memory");
        } else {
            XB_SPIN(xb_ld(&bar[XB_XGEN(b.x)]) == gen, bar);
            __builtin_amdgcn_fence(__ATOMIC_ACQUIRE, "agent");
            asm volatile("s_waitcnt vmcnt(0)" ::: "memory");
        }
    }
    __syncthreads();
}

struct Args { const float* in[17]; float* out; unsigned char* ws; int ph_lo, ph_hi; };
#define GAS __attribute__((address_space(1)))
__device__ __forceinline__ const float* karg(int i) {
    const unsigned long long* ka = (const unsigned long long*)__builtin_amdgcn_kernarg_segment_ptr(); asm volatile("" : "+s"(ka));
    return (const float*)(const GAS float*)ka[i];
}
__global__ void __launch_bounds__(NTHR, 2) fwd_megakernel(Args args) {
    extern __shared__ __attribute__((aligned(16))) unsigned char lds_raw[];
    LAS unsigned char* lds = (LAS unsigned char*)lds_raw;
    cg::grid_group grid = cg::this_grid();
    const int tid = threadIdx.x, lane = tid & 63, wave = __builtin_amdgcn_readfirstlane(tid >> 6);
    const int G = gridDim.x;
    unsigned char* ws = args.ws;
    bf16_t* WT = (bf16_t*)(ws + WS_WT); bf16_t* WOT = (bf16_t*)(ws + WS_WOUT); bf16_t* H = (bf16_t*)(ws + WS_H);
    bf16_t* PN = (bf16_t*)(ws + WS_PN); bf16_t* PT = (bf16_t*)(ws + WS_PT);
    bf16_t* SS = (bf16_t*)(ws + WS_SS);
    bf16_t* MX = (bf16_t*)(ws + WS_PT);
    float* gdec = (float*)(ws + WS_GDEC); float* sdec = (float*)(ws + WS_SDEC);
    const int lo = args.ph_lo, hi = args.ph_hi;
    volatile LAS unsigned* bst = (volatile LAS unsigned*)(lds + LDS_BAR_OFF);
    if (tid < 2) bst[tid] = 0u;
    __syncthreads();
    XcdBarrier xbar = xcd_barrier_post((unsigned*)(ws + WS_BAR), bst);
    if (lo < 0) grid.sync();
#define IN(k) (lo <= (k) && (k) < hi)
#define SEAM(k) do { if (IN(k) && IN((k) + 1)) xcd_barrier(xbar); } while (0)

    if (IN(0)) { phase0(lds, karg(1), karg(2), karg(3), karg(5), karg(15), ws, tid, wave, lane); }
    SEAM(0);
    if (IN(1)) { phase1(karg(0), karg(4), ws, H, wave, lane); }
    SEAM(1);
    if (IN(2)) {
        { pg8::Gemm g{H, WT, M, NPN, D, D, D}; pg8::StaticOrder S; S.init(M, NPN, G, (int)blockIdx.x);
          pg8::EpiBf16<0> E{PN, NPN, nullptr, 0, 0, 1.f};
          pg8::gemm_phase<pg8::EpiBf16<0>, pg8::StaticOrder, true, true>(lds, g, S, E); }
        { pg8::Gemm g{WT + (size_t)NPN * D, H, NPT, M, D, D, D}; pg8::StaticOrder S; S.init(NPT, M, G, (int)blockIdx.x);
          pg8::EpiBf16<0> E{PT, M, nullptr, 0, 0, 1.f};
          pg8::gemm_phase<pg8::EpiBf16<0>, pg8::StaticOrder, true, true>(lds, g, S, E); }
    }
    SEAM(2);
    if (IN(3)) {
        for (int it = blockIdx.x; it < 1024; it += G) gla_state_item(lds, PN, PT, karg(6), karg(7), gdec, (unsigned char*)args.out, it, tid, wave, lane);
        for (int it = blockIdx.x; it < 256; it += G) ssd_state_item(lds, PN, PT, karg(9), karg(10), karg(11), karg(12), sdec, SS, it, tid, wave, lane);
    }
    SEAM(3);
    if (IN(4)) { scan_gla((unsigned char*)args.out, gdec, tid); scan_ssd(SS, sdec, tid); }
    SEAM(4);
    if (IN(5)) {
        for (int it = blockIdx.x; it < 1024; it += G) gla_out_item(lds, PN, PT, karg(6), karg(7), karg(8), (unsigned char*)args.out, it, tid, wave, lane);
        for (int it = blockIdx.x; it < 256; it += G) ssd_out_item(lds, PN, PT, karg(9), karg(10), karg(11), karg(12), karg(13), karg(14), SS, it, tid, wave, lane);
    }
    SEAM(5);
    if (IN(6)) {
        pg8::Gemm g{PN, WOT, M, D, DMIX, NPN, DMIX}; pg8::StaticOrder S; S.init(M, D, G, (int)blockIdx.x);
        pg8::EpiBf16<0> E{MX, D, nullptr, 0, 0, 1.f};
        pg8::gemm_phase<pg8::EpiBf16<0>, pg8::StaticOrder, true, true>(lds, g, S, E);
    }
    SEAM(6);
    if (IN(7)) { phase7(karg(0), MX, karg(16), ws, (float*)karg(17), wave, lane); }
#undef IN
#undef SEAM
}

extern "C" void kernel_launch(void* const* d_in, const int* in_sizes, int n_in, void* d_out, int out_size, void* d_ws, size_t ws_size, hipStream_t stream) {
    static int grid = 0;
    if (grid == 0) {
        if (n_in != 17 || out_size != M * D || ws_size < WS_END) { fprintf(stderr, "kernel_launch: unexpected shapes (n_in %d, out %d, ws %zu)\n", n_in, out_size, ws_size); grid = -1; return; }
        int dev = 0, cus = 0, per_cu = 0;
        hipGetDevice(&dev);
        hipDeviceGetAttribute(&cus, hipDeviceAttributeMultiprocessorCount, dev);
        if (hipFuncSetAttribute((const void*)fwd_megakernel, hipFuncAttributeMaxDynamicSharedMemorySize, LDS_BYTES) != hipSuccess) { fprintf(stderr, "kernel_launch: hipFuncSetAttribute failed\n"); grid = -1; return; }
        if (hipOccupancyMaxActiveBlocksPerMultiprocessor(&per_cu, (const void*)fwd_megakernel, NTHR, LDS_BYTES) != hipSuccess || per_cu < 1) { fprintf(stderr, "kernel_launch: occupancy query gave %d\n", per_cu); per_cu = 1; }
        (void)hipGetLastError();
        grid = cus * per_cu;
        fprintf(stderr, "kernel_launch: grid %d (%d CUs x %d)\n", grid, cus, per_cu);
    }
    if (grid < 0) return;
    Args a{};
    for (int i = 0; i < 17; ++i) a.in[i] = (const float*)d_in[i];
    a.out = (float*)d_out; a.ws = (unsigned char*)d_ws;
#if MK_N_LAUNCHES == 1
    if (hipMemsetAsync((char*)d_ws + WS_BAR, 0, BAR_BYTES, stream) != hipSuccess) { fprintf(stderr, "kernel_launch: hipMemsetAsync failed\n"); return; }
    a.ph_lo = 0; a.ph_hi = NPHASE;
    void* kargs[] = {&a};
    hipError_t e = hipLaunchCooperativeKernel((const void*)fwd_megakernel, dim3(grid), dim3(NTHR), kargs, LDS_BYTES, stream);
    if (e != hipSuccess) fprintf(stderr, "kernel_launch: cooperative launch failed: %s (grid %d)\n", hipGetErrorString(e), grid);
#else
    for (int p = 0; p < NPHASE; ++p) {
        a.ph_lo = p; a.ph_hi = p + 1;
        hipLaunchKernelGGL(fwd_megakernel, dim3(grid), dim3(NTHR), LDS_BYTES, stream, a);
    }
#endif
}
```
